# Optimizing an MI355X kernel written in HIP

```python
import jax, jax.numpy as jnp
from jax import lax
import numpy as np

D_MODEL = 2048
BATCH = 4
SEQ = 4096
DEPTH = 1
DEC_BATCH = 1
DEC_SEQ = 16384
PAST_LEN = 128

HEAD_DIM = 128
N_ATTN_HEADS = 8
N_KV_HEADS = 2
ATTN_WIDTH = N_ATTN_HEADS * HEAD_DIM
KV_WIDTH = N_KV_HEADS * HEAD_DIM
Q_BLOCK = 128
ROPE_THETA = 10000.0
ROPE_AXIS_DIM = HEAD_DIM // 2
GRID_W = 64
N_GLA_HEADS = 4
GLA_DK = 128
GLA_DV = 256
GLA_K_WIDTH = N_GLA_HEADS * GLA_DK
GLA_V_WIDTH = N_GLA_HEADS * GLA_DV
GATE_RANK = 16
GATE_TAU = 16.0
GLA_CHUNK = 64
MIX_WIDTH = ATTN_WIDTH + GLA_V_WIDTH
IN_SIZES = (ATTN_WIDTH, KV_WIDTH, KV_WIDTH, GLA_K_WIDTH, GLA_K_WIDTH, GLA_V_WIDTH, GLA_V_WIDTH, GATE_RANK, GATE_RANK)
D_IN = ATTN_WIDTH + 2 * KV_WIDTH + 2 * GLA_K_WIDTH + 2 * GLA_V_WIDTH + 2 * GATE_RANK
D_FF = -(-8 * D_MODEL // (3 * 256)) * 256
D_PLE = 256
EPS = 1e-6

kernel_name = "hymba_gqa_gla_bidir_encoder"


def rmsnorm(x, g):
    xf = x.astype(jnp.float32)
    y = xf * lax.rsqrt(jnp.mean(xf * xf, axis=-1, keepdims=True) + EPS)
    return (y * g.astype(jnp.float32)).astype(x.dtype)


def split_cols(z, sizes):
    out = []
    off = 0
    for s in sizes:
        out.append(z[..., off:off + s])
        off += s
    return out


def axial_rope_tables(seq_len):
    n_rows = seq_len // GRID_W
    row = jnp.repeat(jnp.arange(n_rows, dtype=jnp.float32), GRID_W)
    col = jnp.tile(jnp.arange(GRID_W, dtype=jnp.float32), n_rows)
    freqs = ROPE_THETA ** (-jnp.arange(0, ROPE_AXIS_DIM, 2, dtype=jnp.float32) / ROPE_AXIS_DIM)
    ang_r = row[:, None] * freqs[None, :]
    ang_c = col[:, None] * freqs[None, :]
    return (jnp.cos(ang_r)[:, None, :], jnp.sin(ang_r)[:, None, :],
            jnp.cos(ang_c)[:, None, :], jnp.sin(ang_c)[:, None, :])


def rotate_half(x, cos, sin):
    h = x.shape[-1] // 2
    x1, x2 = x[..., :h], x[..., h:]
    return jnp.concatenate([x1 * cos - x2 * sin, x2 * cos + x1 * sin], axis=-1)


def apply_axial_rope(x, rope):
    cos_r, sin_r, cos_c, sin_c = rope
    xf = x.astype(jnp.float32)
    xr = rotate_half(xf[..., :ROPE_AXIS_DIM], cos_r, sin_r)
    xc = rotate_half(xf[..., ROPE_AXIS_DIM:], cos_c, sin_c)
    return jnp.concatenate([xr, xc], axis=-1).astype(x.dtype)


def block_attention(q, k, v):
    B, S, _, D = q.shape
    nb = S // Q_BLOCK
    G = N_ATTN_HEADS // N_KV_HEADS
    qb = q.reshape(B, nb, Q_BLOCK, N_KV_HEADS, G, D).transpose(1, 0, 3, 4, 2, 5)
    kt = k.transpose(0, 2, 1, 3)
    vt = v.transpose(0, 2, 1, 3)
    scale = D ** -0.5

    def one_block(qblk):
        s = jnp.einsum('bhgqd,bhkd->bhgqk', qblk, kt).astype(jnp.float32) * scale
        p = jax.nn.softmax(s, axis=-1).astype(vt.dtype)
        return jnp.einsum('bhgqk,bhkd->bhgqd', p, vt)

    o = lax.map(one_block, qb)
    return o.transpose(1, 0, 4, 2, 3, 5).reshape(B, S, N_ATTN_HEADS * D)


def gla_chunked(q, k, v, log_a):
    B, H, S, DK = q.shape
    DV = v.shape[-1]
    C = GLA_CHUNK
    N = S // C
    q = q.reshape(B, H, N, C, DK)
    k = k.reshape(B, H, N, C, DK)
    v = v.reshape(B, H, N, C, DV)
    b = jnp.cumsum(log_a.reshape(B, H, N, C, DK), axis=3)
    b_last = b[:, :, :, -1:, :]
    q_dec = q * jnp.exp(b)
    k_dec = k * jnp.exp(-b)
    mask = jnp.tril(jnp.ones((C, C), dtype=bool))
    A = jnp.where(mask, jnp.einsum('bhnid,bhnjd->bhnij', q_dec, k_dec), 0.0)
    o_intra = jnp.einsum('bhnij,bhnjv->bhniv', A, v)
    chunk_kv = jnp.einsum('bhncd,bhncv->nbhdv', k * jnp.exp(b_last - b), v)
    chunk_decay = jnp.moveaxis(jnp.exp(b_last[:, :, :, 0, :]), 2, 0)

    def step(state, inp):
        kv, dec = inp
        return dec[..., None] * state + kv, state

    _, states = lax.scan(step, jnp.zeros((B, H, DK, DV), jnp.float32), (chunk_kv, chunk_decay))
    o_inter = jnp.einsum('bhncd,nbhdv->bhncv', q_dec, states)
    return (o_intra + o_inter).reshape(B, H, S, DV)


def to_heads(t, n_heads):
    B, S, W = t.shape
    return t.reshape(B, S, n_heads, W // n_heads).transpose(0, 2, 1, 3)


def gla_mixer(q, k, v, g_out, gf_low, gb_low, w_gf_up, b_gf, w_gb_up, b_gb, g_gla_norm):
    B, S, _ = q.shape
    f32 = jnp.float32
    qh = to_heads(q, N_GLA_HEADS).astype(f32) * (GLA_DK ** -0.5)
    kh = to_heads(k, N_GLA_HEADS).astype(f32)
    vh = to_heads(v, N_GLA_HEADS).astype(f32)
    la_f = to_heads(jax.nn.log_sigmoid((gf_low @ w_gf_up + b_gf).astype(f32)) / GATE_TAU, N_GLA_HEADS)
    la_b = to_heads(jax.nn.log_sigmoid((gb_low @ w_gb_up + b_gb).astype(f32)) / GATE_TAU, N_GLA_HEADS)
    o_f = gla_chunked(qh, kh, vh, la_f)
    flip = lambda t: jnp.flip(t, axis=2)
    o_b = flip(gla_chunked(flip(qh), flip(kh), flip(vh), flip(la_b)))
    diag = jnp.sum(qh * kh, axis=-1, keepdims=True) * vh
    o = (o_f + o_b - diag).transpose(0, 2, 1, 3)
    o = rmsnorm(o, g_gla_norm) * jax.nn.silu(g_out.astype(f32)).reshape(B, S, N_GLA_HEADS, GLA_DV)
    return o.reshape(B, S, GLA_V_WIDTH).astype(q.dtype)


def encoder_layer(x, p, rope, g_pre_mix, w_in, g_q, g_k, w_gf_up, b_gf, w_gb_up, b_gb, g_gla_norm,
                  w_out, g_post_mix, g_pre_ffn, w_gate_up, w_down, g_post_ffn,
                  g_ple_pre, w_ple_gate, w_ple_proj, g_ple_post):
    B, S, _ = x.shape
    h = rmsnorm(x, g_pre_mix)
    z = h @ w_in
    qa, ka, va, qg, kg, vg, og, gf_low, gb_low = split_cols(z, IN_SIZES)
    qa = apply_axial_rope(rmsnorm(qa.reshape(B, S, N_ATTN_HEADS, HEAD_DIM), g_q), rope)
    ka = apply_axial_rope(rmsnorm(ka.reshape(B, S, N_KV_HEADS, HEAD_DIM), g_k), rope)
    va = va.reshape(B, S, N_KV_HEADS, HEAD_DIM)
    attn_out = block_attention(qa, ka, va)
    gla_out = gla_mixer(qg, kg, vg, og, gf_low, gb_low, w_gf_up, b_gf, w_gb_up, b_gb, g_gla_norm)
    mix = jnp.concatenate([attn_out, gla_out], axis=-1) @ w_out
    x = x + rmsnorm(mix, g_post_mix)
    gate, up = jnp.split(rmsnorm(x, g_pre_ffn) @ w_gate_up, 2, axis=-1)
    x = x + rmsnorm((jax.nn.silu(gate) * up) @ w_down, g_post_ffn)
    pg = jax.nn.sigmoid(rmsnorm(x, g_ple_pre) @ w_ple_gate)
    x = x + rmsnorm((p @ w_ple_proj) * pg, g_ple_post)
    return x


def setup_inputs(seed: int = 0) -> dict:
    key = jax.random.key(seed)
    ks = iter(jax.random.split(key, 32))
    nrm = lambda shape: jax.random.normal(next(ks), shape, jnp.float32)
    gain = lambda n: 1.0 + 0.02 * nrm((DEPTH, n))
    return {
        "x_prompt": nrm((BATCH, SEQ, D_MODEL)),
        "x_sample": nrm((DEC_BATCH, DEC_SEQ, D_MODEL)),
        "p_prompt": nrm((DEPTH, BATCH, SEQ, D_PLE)),
        "p_sample": nrm((DEPTH, DEC_BATCH, DEC_SEQ, D_PLE)),
        "g_pre_mix": gain(D_MODEL),
        "w_in": nrm((DEPTH, D_MODEL, D_IN)) * D_MODEL ** -0.5,
        "g_q": gain(HEAD_DIM),
        "g_k": gain(HEAD_DIM),
        "w_gf_up": nrm((DEPTH, GATE_RANK, GLA_K_WIDTH)) * GATE_RANK ** -0.5,
        "b_gf": 1.0 + 0.1 * nrm((DEPTH, GLA_K_WIDTH)),
        "w_gb_up": nrm((DEPTH, GATE_RANK, GLA_K_WIDTH)) * GATE_RANK ** -0.5,
        "b_gb": 1.0 + 0.1 * nrm((DEPTH, GLA_K_WIDTH)),
        "g_gla_norm": gain(GLA_DV),
        "w_out": nrm((DEPTH, MIX_WIDTH, D_MODEL)) * MIX_WIDTH ** -0.5,
        "g_post_mix": gain(D_MODEL),
        "g_pre_ffn": gain(D_MODEL),
        "w_gate_up": nrm((DEPTH, D_MODEL, 2 * D_FF)) * D_MODEL ** -0.5,
        "w_down": nrm((DEPTH, D_FF, D_MODEL)) * D_FF ** -0.5,
        "g_post_ffn": gain(D_MODEL),
        "g_ple_pre": gain(D_MODEL),
        "w_ple_gate": nrm((DEPTH, D_MODEL, D_MODEL)) * D_MODEL ** -0.5,
        "w_ple_proj": nrm((DEPTH, D_PLE, D_MODEL)) * D_PLE ** -0.5,
        "g_ple_post": gain(D_MODEL),
    }


def reference(x_prompt, x_sample, p_prompt, p_sample, g_pre_mix, w_in, g_q, g_k, w_gf_up, b_gf,
              w_gb_up, b_gb, g_gla_norm, w_out, g_post_mix, g_pre_ffn, w_gate_up, w_down, g_post_ffn,
              g_ple_pre, w_ple_gate, w_ple_proj, g_ple_post):
    rope_prompt = axial_rope_tables(x_prompt.shape[1])
    rope_sample = axial_rope_tables(x_sample.shape[1])
    y_prompt = x_prompt
    y_sample = x_sample
    for i in range(DEPTH):
        w = (g_pre_mix[i], w_in[i], g_q[i], g_k[i], w_gf_up[i], b_gf[i], w_gb_up[i], b_gb[i],
             g_gla_norm[i], w_out[i], g_post_mix[i], g_pre_ffn[i], w_gate_up[i], w_down[i],
             g_post_ffn[i], g_ple_pre[i], w_ple_gate[i], w_ple_proj[i], g_ple_post[i])
        y_prompt = encoder_layer(y_prompt, p_prompt[i], rope_prompt, *w)
        y_sample = encoder_layer(y_sample, p_sample[i], rope_sample, *w)
    return (y_prompt, y_sample)
```

```cpp
#include <hip/hip_runtime.h>
#include <hip/hip_cooperative_groups.h>
#include <hip/hip_bf16.h>
#include <cstdio>
#include <cstdint>
namespace cg = cooperative_groups;

#ifndef ONE_LAUNCH
#define ONE_LAUNCH 1
#endif

namespace pg8 {
#define PG8_LAS __attribute__((address_space(3)))
typedef unsigned short bf16_t;
typedef short bf16x8 __attribute__((ext_vector_type(8)));
typedef float f32x4 __attribute__((ext_vector_type(4)));
typedef unsigned u32x4 __attribute__((ext_vector_type(4)));
constexpr int BM = 256, BK = 64, HALF = 128, HTB = HALF * BK * 2  , STAGE_BYTES = 8 * HTB, NXCD = 8, WGM = 8;

__host__ __device__ __forceinline__ int lds_byte(int r, int c) { const int st = (r >> 4) * 2 + (c >> 5), rr = r & 15, cc = c & 31, ob = rr * 64 + cc * 2; return st * 1024 + (ob ^ (((ob >> 9) & 1) << 5)); }
__host__ __device__ __forceinline__ void stage_rc(int b, int& R, int& C) { const int st = b / 1024, sb = b % 1024, swz = sb ^ (((sb >> 9) & 1) << 5); R = (st >> 1) * 16 + swz / 64; C = (st & 1) * 32 + (swz % 64) / 2; }
__host__ __device__ __forceinline__ int perm32(int rho) { const int n = rho >> 4, i = rho & 15; return 8 * (i >> 2) + 4 * n + (i & 3); }

struct Unit { int pm, pn; };
struct Gemm { const bf16_t* A; const bf16_t* Bt; int M, N, K; };

struct StaticOrder {
    int nM, nN, nwg, G, c;
    __host__ __device__ void init(int M, int N, int G_, int c_) { nM = M / BM; nN = N / BM; nwg = nM * nN; G = G_; c = c_; }
    __host__ __device__ bool next(int i, Unit& u) const {
        const long L = (long)i * G + c; if (L >= nwg) return false;
        int wgid = (int)L; { const int q = nwg / NXCD, r = nwg % NXCD, xcd = wgid % NXCD, off = wgid / NXCD; wgid = (xcd < r ? xcd * (q + 1) : r * (q + 1) + (xcd - r) * q) + off; }
        const int nig = WGM * nN, gid = wgid / nig, fm = gid * WGM, gsz = (nM - fm) < WGM ? (nM - fm) : WGM;
        u.pm = fm + ((wgid % nig) % gsz); u.pn = (wgid % nig) / gsz; return true;
    }
    __device__ __forceinline__ void a_ready(const Unit&) const {}
    __device__ __forceinline__ void done(const Unit&) const {}
};

__device__ __forceinline__ unsigned cvt_pk_bf16(float lo, float hi) { unsigned r; asm volatile("v_cvt_pk_bf16_f32 %0, %1, %2" : "=v"(r) : "v"(lo), "v"(hi)); return r; }

__device__ __forceinline__ u32x4 pack8(const f32x4 v0, const f32x4 v1) { u32x4 w; w.x = cvt_pk_bf16(v0[0], v0[1]); w.y = cvt_pk_bf16(v0[2], v0[3]); w.z = cvt_pk_bf16(v1[0], v1[1]); w.w = cvt_pk_bf16(v1[2], v1[3]); return w; }
__device__ __forceinline__ float bf_lo(unsigned w) { return __builtin_bit_cast(float, w << 16); }
__device__ __forceinline__ float bf_hi(unsigned w) { return __builtin_bit_cast(float, w & 0xffff0000u); }

struct EpiPlain {
    static constexpr bool PERM = true, AFTER_DRAIN = false;
    bf16_t* O; int ldc;
    __device__ __forceinline__ void operator()(const f32x4 (&acc)[2][2][4][2], const Unit& u, int wr, int wc, int fr, int fq) const {
        const int row0 = u.pm * BM + wr * 64 + fr, col0 = u.pn * BM + wc * 32 + 8 * fq;
#pragma unroll
        for (int ai = 0; ai < 2; ++ai)
#pragma unroll
            for (int m = 0; m < 4; ++m) { bf16_t* rowp = O + (size_t)(row0 + ai * HALF + m * 16) * ldc + col0;
#pragma unroll
                for (int bj = 0; bj < 2; ++bj) *(u32x4*)(rowp + bj * HALF) = pack8(acc[ai][bj][m][0], acc[ai][bj][m][1]); }
    }
};
struct EpiSplit {
    static constexpr bool PERM = true, AFTER_DRAIN = false;
    bf16_t *MIX, *KA, *VA, *QG, *KG, *VG; float* LR;
    __device__ __forceinline__ void operator()(const f32x4 (&acc)[2][2][4][2], const Unit& u, int wr, int wc, int fr, int fq) const {
        const int pn = u.pn; const int row0 = u.pm * BM + wr * 64 + fr;
        if (pn == 18) {
            if (wc == 0) {
#pragma unroll
                for (int ai = 0; ai < 2; ++ai)
#pragma unroll
                    for (int m = 0; m < 4; ++m) { float* rp = LR + (size_t)(row0 + ai * HALF + m * 16) * 32 + 8 * fq; *(f32x4*)rp = acc[ai][0][m][0]; *(f32x4*)(rp + 4) = acc[ai][0][m][1]; }
            }
            return;
        }
        bf16_t* base; int ld;
        if (pn < 4) { base = MIX + pn * 256; ld = 2048; }
        else if (pn == 4) { base = KA; ld = 256; }
        else if (pn == 5) { base = VA; ld = 256; }
        else if (pn < 8) { base = QG + (pn - 6) * 256; ld = 512; }
        else if (pn < 10) { base = KG + (pn - 8) * 256; ld = 512; }
        else if (pn < 14) { base = VG + (pn - 10) * 256; ld = 1024; }
        else { base = MIX + 1024 + (pn - 14) * 256; ld = 2048; }
        const int col0 = wc * 32 + 8 * fq;
#pragma unroll
        for (int ai = 0; ai < 2; ++ai)
#pragma unroll
            for (int m = 0; m < 4; ++m) { bf16_t* rowp = base + (size_t)(row0 + ai * HALF + m * 16) * ld + col0;
#pragma unroll
                for (int bj = 0; bj < 2; ++bj) *(u32x4*)(rowp + bj * HALF) = pack8(acc[ai][bj][m][0], acc[ai][bj][m][1]); }
    }
};
struct EpiSwiGLU {
    static constexpr bool PERM = true, AFTER_DRAIN = false;
    bf16_t* O; int ldc;
    __device__ __forceinline__ void operator()(const f32x4 (&acc)[2][2][4][2], const Unit& u, int wr, int wc, int fr, int fq) const {
        const int row0 = u.pm * BM + wr * 64 + fr, col0 = u.pn * HALF + wc * 32 + 8 * fq;
#pragma unroll
        for (int ai = 0; ai < 2; ++ai)
#pragma unroll
            for (int m = 0; m < 4; ++m) { f32x4 h[2];
#pragma unroll
                for (int n = 0; n < 2; ++n)
#pragma unroll
                    for (int e = 0; e < 4; ++e) { const float g = acc[ai][0][m][n][e], up = acc[ai][1][m][n][e]; h[n][e] = g * up * __builtin_amdgcn_rcpf(1.0f + __expf(-g)); }
                *(u32x4*)(O + (size_t)(row0 + ai * HALF + m * 16) * ldc + col0) = pack8(h[0], h[1]); }
    }
};
struct EpiMulSig {
    static constexpr bool PERM = true, AFTER_DRAIN = false;
    bf16_t* O; int ldc;
    __device__ __forceinline__ void operator()(const f32x4 (&acc)[2][2][4][2], const Unit& u, int wr, int wc, int fr, int fq) const {
        const int row0 = u.pm * BM + wr * 64 + fr, col0 = u.pn * BM + wc * 32 + 8 * fq;
#pragma unroll
        for (int ai = 0; ai < 2; ++ai)
#pragma unroll
            for (int m = 0; m < 4; ++m) { bf16_t* rowp = O + (size_t)(row0 + ai * HALF + m * 16) * ldc + col0;
#pragma unroll
                for (int bj = 0; bj < 2; ++bj) { const u32x4 p = *(const u32x4*)(rowp + bj * HALF); f32x4 v0 = acc[ai][bj][m][0], v1 = acc[ai][bj][m][1];
#pragma unroll
                    for (int e = 0; e < 4; ++e) { v0[e] = __builtin_amdgcn_rcpf(1.0f + __expf(-v0[e])); v1[e] = __builtin_amdgcn_rcpf(1.0f + __expf(-v1[e])); }
                    v0[0] *= bf_lo(p.x); v0[1] *= bf_hi(p.x); v0[2] *= bf_lo(p.y); v0[3] *= bf_hi(p.y); v1[0] *= bf_lo(p.z); v1[1] *= bf_hi(p.z); v1[2] *= bf_lo(p.w); v1[3] *= bf_hi(p.w);
                    *(u32x4*)(rowp + bj * HALF) = pack8(v0, v1); } }
    }
};
template <class Epi, class Sched, bool ALIGN_EPI = false, bool SP2 = false>
__device__ __forceinline__ void gemm_phase(PG8_LAS unsigned char* lds, const Gemm g, const Sched& S, const Epi& E) {
    int tid_o = threadIdx.x; asm volatile("" : "+v"(tid_o));
    const int tid = tid_o, wid = __builtin_amdgcn_readfirstlane(tid >> 6), lane = tid & 63, wr = wid >> 2, wc = wid & 3, fr = lane & 15, fq = lane >> 4;
    const int K = g.K, nt = K / BK;
    unsigned voffA[2], voffB[2];
#pragma unroll
    for (int i = 0; i < 2; ++i) { int R, C; stage_rc(tid * 16 + i * 8192, R, C); const int Rb = Epi::PERM ? ((R & ~31) + perm32(R & 31)) : R;
        voffA[i] = (unsigned)(R * K + C) * 2u; voffB[i] = (unsigned)(Rb * K + C) * 2u; }
    const size_t kstep = (size_t)(BK * 2);
    const size_t hstep = (size_t)HALF * K * 2;
    const size_t tstep = 2 * hstep;
    const unsigned ldsw = (unsigned)wid * 1024u;
    const int aoff = lds_byte(wr * 64 + fr, fq * 8), boff = lds_byte(wc * 32 + fr, fq * 8);
#define PG8_SA(b, h) (((b) * 2 + (h)) * HTB)
#define PG8_SB(b, h) ((4 + (b) * 2 + (h)) * HTB)
#define PG8_STAGE(bufoff, gbase, voff) do { _Pragma("unroll") for (int _i = 0; _i < 2; ++_i) \
        __builtin_amdgcn_global_load_lds((const unsigned*)((const char*)(gbase) + (voff)[_i]), (PG8_LAS unsigned*)(lds + (bufoff) + ldsw + _i * 8192), 16, 0, 0); } while (0)
#define PG8_LDA(dst, b, h) do { _Pragma("unroll") for (int m = 0; m < 4; ++m) _Pragma("unroll") for (int k = 0; k < 2; ++k) dst[m][k] = *(const PG8_LAS bf16x8*)(lds + PG8_SA(b, h) + aoff + m * 2048 + k * 1024); } while (0)
#define PG8_LDB(dst, b, h) do { _Pragma("unroll") for (int n = 0; n < 2; ++n) _Pragma("unroll") for (int k = 0; k < 2; ++k) dst[n][k] = *(const PG8_LAS bf16x8*)(lds + PG8_SB(b, h) + boff + n * 2048 + k * 1024); } while (0)
#define PG8_MMA(ai, bj, At, Bt) do { __builtin_amdgcn_s_setprio(1); _Pragma("unroll") for (int m = 0; m < 4; ++m) _Pragma("unroll") for (int n = 0; n < 2; ++n) _Pragma("unroll") for (int k = 0; k < 2; ++k) \
        acc[ai][bj][m][n] = __builtin_amdgcn_mfma_f32_16x16x32_bf16(Bt[n][k], At[m][k], acc[ai][bj][m][n], 0, 0, 0); __builtin_amdgcn_s_setprio(0); } while (0)
#define PG8_WAIT_V(n) asm volatile("s_waitcnt vmcnt(" #n ")" ::: "memory")
#define PG8_WAIT_L(n) asm volatile("s_waitcnt lgkmcnt(" #n ")" ::: "memory")
#define PG8_BAR __builtin_amdgcn_s_barrier()
#define PG8_SCHED __builtin_amdgcn_sched_barrier(0)
    Unit cur, nxt; int ui = 0;
    if (!S.next(0, cur)) return;
    f32x4 acc[2][2][4][2];
#pragma unroll
    for (int a = 0; a < 2; ++a)
#pragma unroll
        for (int b = 0; b < 2; ++b)
#pragma unroll
            for (int m = 0; m < 4; ++m)
#pragma unroll
                for (int n = 0; n < 2; ++n) acc[a][b][m][n] = (f32x4){0.f, 0.f, 0.f, 0.f};
    bf16x8 At[4][2], B0[2][2], B1[2][2];
    const char* cA = (const char*)g.A + (size_t)cur.pm * tstep; const char* cB = (const char*)g.Bt + (size_t)cur.pn * tstep;
    S.a_ready(cur);
    if constexpr (SP2) {
        PG8_STAGE(PG8_SB(0, 0), cB, voffB); PG8_STAGE(PG8_SB(0, 1), cB + hstep, voffB); PG8_STAGE(PG8_SA(0, 0), cA, voffA); PG8_STAGE(PG8_SA(0, 1), cA + hstep, voffA);
        if (wr == 1) PG8_BAR;
        PG8_WAIT_V(2); PG8_BAR;
        PG8_STAGE(PG8_SB(1, 0), cB + kstep, voffB); PG8_STAGE(PG8_SA(1, 0), cA + kstep, voffA); PG8_STAGE(PG8_SB(1, 1), cB + hstep + kstep, voffB);
        PG8_WAIT_V(6); PG8_BAR;
    } else {
        PG8_STAGE(PG8_SB(0, 0), cB, voffB); PG8_STAGE(PG8_SA(0, 0), cA, voffA); PG8_STAGE(PG8_SB(0, 1), cB + hstep, voffB); PG8_STAGE(PG8_SA(0, 1), cA + hstep, voffA);
        if (wr == 1) PG8_BAR;
        PG8_WAIT_V(4); PG8_BAR;
        PG8_STAGE(PG8_SB(1, 0), cB + kstep, voffB); PG8_STAGE(PG8_SA(1, 0), cA + kstep, voffA); PG8_STAGE(PG8_SB(1, 1), cB + hstep + kstep, voffB);
        PG8_WAIT_V(6); PG8_BAR;
    }
    for (;;) {
        const bool has_next = S.next(ui + 1, nxt);
        const char* nA = has_next ? (const char*)g.A + (size_t)nxt.pm * tstep : cA; const char* nB = has_next ? (const char*)g.Bt + (size_t)nxt.pn * tstep : cB;
        for (int t = 0; t < nt; t += 2) {
            const bool last = (t == nt - 2);
            const char* a1 = cA + (size_t)(t + 1) * kstep;
            const char* a2 = last ? nA : cA + (size_t)(t + 2) * kstep; const char* b2 = last ? nB : cB + (size_t)(t + 2) * kstep;
            const char* a3 = a2 + kstep; const char* b3 = b2 + kstep;
            if (last && has_next) S.a_ready(nxt);
            if constexpr (SP2) {
            PG8_LDB(B0, 0, 0); PG8_LDB(B1, 0, 1); PG8_SCHED; PG8_LDA(At, 0, 0); PG8_STAGE(PG8_SA(1, 1), a1 + hstep, voffA);
            PG8_WAIT_V(8); PG8_WAIT_L(0); PG8_BAR; PG8_MMA(0, 0, At, B0); PG8_MMA(0, 1, At, B1); PG8_BAR; PG8_SCHED;
            PG8_LDA(At, 0, 1); PG8_STAGE(PG8_SB(0, 0), b2, voffB); PG8_STAGE(PG8_SB(0, 1), b2 + hstep, voffB); PG8_STAGE(PG8_SA(0, 0), a2, voffA);
            PG8_WAIT_V(8); PG8_WAIT_L(0); PG8_BAR; PG8_MMA(1, 0, At, B0); PG8_MMA(1, 1, At, B1); PG8_BAR; PG8_SCHED;
            PG8_LDB(B0, 1, 0); PG8_LDB(B1, 1, 1); PG8_SCHED; PG8_LDA(At, 1, 0); PG8_STAGE(PG8_SA(0, 1), a2 + hstep, voffA);
            PG8_WAIT_V(8); PG8_WAIT_L(0); PG8_BAR; PG8_MMA(0, 0, At, B0); PG8_MMA(0, 1, At, B1); PG8_BAR; PG8_SCHED;
            PG8_LDA(At, 1, 1); PG8_STAGE(PG8_SB(1, 0), b3, voffB); PG8_STAGE(PG8_SB(1, 1), b3 + hstep, voffB); PG8_STAGE(PG8_SA(1, 0), a3, voffA);
            PG8_WAIT_V(8); PG8_WAIT_L(0); PG8_BAR; PG8_MMA(1, 0, At, B0); PG8_MMA(1, 1, At, B1); PG8_BAR; PG8_SCHED;
            } else {
            PG8_LDB(B0, 0, 0); PG8_SCHED; PG8_LDA(At, 0, 0); PG8_STAGE(PG8_SA(1, 1), a1 + hstep, voffA);
            PG8_WAIT_L(8); PG8_BAR; PG8_WAIT_L(0); PG8_MMA(0, 0, At, B0); PG8_BAR; PG8_SCHED;
            PG8_LDB(B1, 0, 1); PG8_STAGE(PG8_SB(0, 0), b2, voffB);
            PG8_BAR; PG8_WAIT_L(0); PG8_MMA(0, 1, At, B1); PG8_BAR;
            PG8_LDA(At, 0, 1); PG8_STAGE(PG8_SA(0, 0), a2, voffA);
            PG8_BAR; PG8_WAIT_L(0); PG8_MMA(1, 0, At, B0); PG8_BAR; PG8_SCHED;
            PG8_STAGE(PG8_SB(0, 1), b2 + hstep, voffB);
            PG8_WAIT_V(6); PG8_BAR; PG8_MMA(1, 1, At, B1); PG8_BAR;
            PG8_LDB(B0, 1, 0); PG8_SCHED; PG8_LDA(At, 1, 0); PG8_STAGE(PG8_SA(0, 1), a2 + hstep, voffA);
            PG8_WAIT_L(8); PG8_BAR; PG8_WAIT_L(0); PG8_MMA(0, 0, At, B0); PG8_BAR; PG8_SCHED;
            PG8_LDB(B1, 1, 1); PG8_STAGE(PG8_SB(1, 0), b3, voffB);
            PG8_BAR; PG8_WAIT_L(0); PG8_MMA(0, 1, At, B1); PG8_BAR;
            PG8_LDA(At, 1, 1); PG8_STAGE(PG8_SA(1, 0), a3, voffA);
            PG8_BAR; PG8_WAIT_L(0); PG8_MMA(1, 0, At, B0); PG8_BAR; PG8_SCHED;
            PG8_STAGE(PG8_SB(1, 1), b3 + hstep, voffB);
            PG8_WAIT_V(6); PG8_BAR; PG8_MMA(1, 1, At, B1); PG8_BAR;
            }
        }
        if constexpr (ALIGN_EPI) { if (wr == 0) PG8_BAR; }
        if constexpr (!Epi::AFTER_DRAIN) { E(acc, cur, wr, wc, fr, fq); S.done(cur); }
        if (!has_next) break;
#pragma unroll
        for (int a = 0; a < 2; ++a)
#pragma unroll
            for (int b = 0; b < 2; ++b)
#pragma unroll
                for (int m = 0; m < 4; ++m)
#pragma unroll
                    for (int n = 0; n < 2; ++n) acc[a][b][m][n] = (f32x4){0.f, 0.f, 0.f, 0.f};
        cur = nxt; cA = nA; cB = nB; ++ui;
        if constexpr (ALIGN_EPI) { if (wr == 1) PG8_BAR; }
    }
    PG8_WAIT_V(0);
    if constexpr (!ALIGN_EPI) { if (wr == 0) PG8_BAR; }
    PG8_BAR;
    if constexpr (Epi::AFTER_DRAIN) { E.fused(acc, cur, wr, wc, fr, fq, lds, wid, lane); S.done(cur); }
#undef PG8_SA
#undef PG8_SB
#undef PG8_STAGE
#undef PG8_LDA
#undef PG8_LDB
#undef PG8_MMA
#undef PG8_WAIT_V
#undef PG8_WAIT_L
#undef PG8_BAR
#undef PG8_SCHED
}
}

namespace att {
using bf16x8 = __attribute__((ext_vector_type(8))) short;
using s16x4  = __attribute__((ext_vector_type(4))) short;
using f32x16 = __attribute__((ext_vector_type(16))) float;
using u32x4  = __attribute__((ext_vector_type(4))) unsigned;
typedef unsigned short bf16_t;
constexpr int   D = 128, NW = 8, QBLK = 32, KVBLK = 64;
constexpr float SCALE = 0.088388347648318440f;
constexpr float THR = 8.f;
constexpr size_t SHM_V = KVBLK * D * 2, SHM_K = KVBLK * D * 2, SHM_ATTN = 2 * SHM_V + 2 * SHM_K + NW * 64 * 4;
#define KSWZ(row, colB) ((row) * 256 + ((colB) ^ (((row) & 7) << 4)))
#define SBAR() __builtin_amdgcn_sched_barrier(0)
__device__ __forceinline__ int crow(int r, int hi) { return (r & 3) + 8 * (r >> 2) + 4 * hi; }
__device__ __forceinline__ unsigned cvtpk(float lo, float hi) { unsigned r; asm volatile("v_cvt_pk_bf16_f32 %0, %1, %2" : "=v"(r) : "v"(lo), "v"(hi)); return r; }
__device__ __forceinline__ bf16_t f2bf(float f) { return (bf16_t)(cvtpk(f, 0.f) & 0xffffu); }
__device__ __forceinline__ float bf2f(bf16_t h) { return __builtin_bit_cast(float, (unsigned)h << 16); }

__device__ __forceinline__ void partialSM(f32x16& p0, f32x16& p1, float& m_reg, float& mn, float& alpha) {
  constexpr float C = SCALE * 1.4426950408889634f;
  float pmax = p0[0]; for (int r = 1; r < 16; ++r) pmax = fmaxf(pmax, p0[r]); for (int r = 0; r < 16; ++r) pmax = fmaxf(pmax, p1[r]);
  { auto rr = __builtin_amdgcn_permlane32_swap(__float_as_uint(pmax), __float_as_uint(pmax), false, false);
    pmax = fmaxf(__uint_as_float(rr[0]), __uint_as_float(rr[1])); }
  if (__builtin_expect(__all(pmax - m_reg <= THR / SCALE), 1)) { mn = m_reg; alpha = 1.f; }
  else { mn = fmaxf(m_reg, pmax); alpha = __builtin_amdgcn_exp2f((m_reg - mn) * C); m_reg = mn; }
  float mnC = -mn * C;
  for (int r = 0; r < 16; ++r) p0[r] = fmaf(p0[r], C, mnC); for (int r = 0; r < 16; ++r) p1[r] = fmaf(p1[r], C, mnC);
  for (int r = 0; r < 16; ++r) p0[r] = __builtin_amdgcn_exp2f(p0[r]);
}
#define PK4(P, BASE, OUT) do { unsigned a0 = cvtpk(P[BASE + 0], P[BASE + 1]), a1 = cvtpk(P[BASE + 2], P[BASE + 3]);   \
    unsigned b0 = cvtpk(P[BASE + 4], P[BASE + 5]), b1 = cvtpk(P[BASE + 6], P[BASE + 7]);                              \
    auto r0 = __builtin_amdgcn_permlane32_swap(a0, b0, false, false); auto r1 = __builtin_amdgcn_permlane32_swap(a1, b1, false, false); \
    u32x4 w = {r0[0], r1[0], r0[1], r1[1]}; OUT = *reinterpret_cast<bf16x8*>(&w); } while (0)
__device__ __forceinline__ void finishSM(f32x16& p0, f32x16& p1, float alpha, float& l_reg, bf16x8& pa0, bf16x8& pa1, bf16x8& pa2, bf16x8& pa3) {
  for (int r = 0; r < 16; ++r) p1[r] = __builtin_amdgcn_exp2f(p1[r]);
  float ps = 0; for (int r = 0; r < 16; ++r) ps += p0[r]; for (int r = 0; r < 16; ++r) ps += p1[r];
  { auto rr = __builtin_amdgcn_permlane32_swap(__float_as_uint(ps), __float_as_uint(ps), false, false);
    ps = __uint_as_float(rr[0]) + __uint_as_float(rr[1]); }
  l_reg = l_reg * alpha + ps;
  PK4(p0, 0, pa0); PK4(p0, 8, pa1); PK4(p1, 0, pa2); PK4(p1, 8, pa3);
}
__device__ __forceinline__ void qkt(f32x16& p0, f32x16& p1, const bf16_t* Ks, const bf16x8* qr, int r32, int hi) {
  p0 = f32x16{}; p1 = f32x16{};
#pragma unroll
  for (int d0 = 0; d0 < 8; ++d0) { int cb = (d0 * 16 + hi * 8) * 2;
    bf16x8 b0 = *reinterpret_cast<const bf16x8*>((const char*)Ks + KSWZ(r32, cb));
    bf16x8 b1 = *reinterpret_cast<const bf16x8*>((const char*)Ks + KSWZ(32 + r32, cb));
    p0 = __builtin_amdgcn_mfma_f32_32x32x16_bf16(b0, qr[d0], p0, 0, 0, 0);
    p1 = __builtin_amdgcn_mfma_f32_32x32x16_bf16(b1, qr[d0], p1, 0, 0, 0); }
}
__device__ __forceinline__ int v_st(int k, int c) { const int kk = (k & ~0xC) | ((k & 4) << 1) | ((k & 8) >> 1); return ((kk >> 3) * 4 + (c >> 5)) * 512 + ((kk & 7) * 32 + (c & 31)) * 2; }
__device__ __forceinline__ int v_rd_base(int lane) { return ((lane & 3) << 3) | (((lane >> 2) & 3) << 6) | (((lane >> 4) & 1) << 5) | (((lane >> 5) & 1) << 8); }
constexpr int v_rd_off(int d0, int ks, int half) { return d0 * 512 + ks * 4096 + half * 2048; }
template <int OFF> __device__ __forceinline__ s16x4 tr_read(int vb) {
  s16x4 r; asm volatile("ds_read_b64_tr_b16 %0, %1 offset:%2" : "=&v"(r) : "v"(vb), "i"(OFF) : "memory"); return r;
}
template <int D0> __device__ __forceinline__ void pv_one(f32x16& od, int vb, bf16x8 pa0, bf16x8 pa1, bf16x8 pa2, bf16x8 pa3) {
  const s16x4 l0 = tr_read<v_rd_off(D0, 0, 0)>(vb), h0 = tr_read<v_rd_off(D0, 0, 1)>(vb), l1 = tr_read<v_rd_off(D0, 1, 0)>(vb), h1 = tr_read<v_rd_off(D0, 1, 1)>(vb);
  const s16x4 l2 = tr_read<v_rd_off(D0, 2, 0)>(vb), h2 = tr_read<v_rd_off(D0, 2, 1)>(vb), l3 = tr_read<v_rd_off(D0, 3, 0)>(vb), h3 = tr_read<v_rd_off(D0, 3, 1)>(vb);
  asm volatile("s_waitcnt lgkmcnt(0)" ::: "memory"); SBAR();
#define PKV(L, H) (bf16x8){L[0], L[1], L[2], L[3], H[0], H[1], H[2], H[3]}
  od = __builtin_amdgcn_mfma_f32_32x32x16_bf16(pa0, PKV(l0, h0), od, 0, 0, 0);
  od = __builtin_amdgcn_mfma_f32_32x32x16_bf16(pa1, PKV(l1, h1), od, 0, 0, 0);
  od = __builtin_amdgcn_mfma_f32_32x32x16_bf16(pa2, PKV(l2, h2), od, 0, 0, 0);
  od = __builtin_amdgcn_mfma_f32_32x32x16_bf16(pa3, PKV(l3, h3), od, 0, 0, 0);
#undef PKV
}
__device__ __forceinline__ void pv_d0(f32x16* o, int vb, bf16x8 pa0, bf16x8 pa1, bf16x8 pa2, bf16x8 pa3) {
  pv_one<0>(o[0], vb, pa0, pa1, pa2, pa3); pv_one<1>(o[1], vb, pa0, pa1, pa2, pa3); pv_one<2>(o[2], vb, pa0, pa1, pa2, pa3); pv_one<3>(o[3], vb, pa0, pa1, pa2, pa3);
}

template <int LDQ, int LDK, int LDO>
__device__ __forceinline__ void attn_dense_body(const bf16_t* Qb, const bf16_t* Kh, const bf16_t* Vh, bf16_t* Ob, int seq, char* lds) {
  constexpr int SDEPTH = 2;
  const int tid = threadIdx.x, wid = tid >> 6, lane = tid & 63, r32 = lane & 31, hi = lane >> 5;
  bf16_t* V_lds = (bf16_t*)lds; bf16_t* K_lds = (bf16_t*)(lds + 2 * SHM_V);
  float* ws = (float*)(lds + 2 * SHM_V + 2 * SHM_K) + wid * 64; float* li_l = ws; float* al_l = ws + 32;
  float m_reg = -1e30f, l_reg = 0; f32x16 o[4] = {}; bf16x8 qr[8];
  const bf16_t* Qw = Qb + (long)(wid * QBLK + r32) * LDQ + hi * 8;
#pragma unroll
  for (int d0 = 0; d0 < 8; ++d0) qr[d0] = *reinterpret_cast<const bf16x8*>(Qw + d0 * 16);
  const int sr = tid >> 4, sc = (tid & 15) * 8, vst0 = v_st(sr, sc), vst1 = v_st(32 + sr, sc);
  const int vb0 = (int)(uintptr_t)V_lds + v_rd_base(lane);
  struct { bf16x8 vs0, vs1, ks0, ks1; } sr_[SDEPTH];
#define LD8(p) (*reinterpret_cast<const bf16x8*>(p))
#define SLOAD(i, k0) do { sr_[i].vs0 = LD8(&Vh[(long)((k0) + sr) * LDK + sc]); sr_[i].vs1 = LD8(&Vh[(long)((k0) + 32 + sr) * LDK + sc]); \
    sr_[i].ks0 = LD8(&Kh[(long)((k0) + sr) * LDK + sc]); sr_[i].ks1 = LD8(&Kh[(long)((k0) + 32 + sr) * LDK + sc]); } while (0)
#define SWRITE(b, i) do { *(bf16x8*)((char*)V_lds + (b) * SHM_V + vst0) = sr_[i].vs0;          \
    *(bf16x8*)((char*)V_lds + (b) * SHM_V + vst1) = sr_[i].vs1; int kc = sc * 2;               \
    *(bf16x8*)((char*)K_lds + (b) * SHM_K + KSWZ(sr, kc)) = sr_[i].ks0;                       \
    *(bf16x8*)((char*)K_lds + (b) * SHM_K + KSWZ(32 + sr, kc)) = sr_[i].ks1; } while (0)
#define SWAIT() asm volatile("s_waitcnt vmcnt(4)" ::: "memory")
#define RESC(a) do { if (__any((a) < 1.f)) { if (hi == 0) al_l[r32] = (a); asm volatile("s_waitcnt lgkmcnt(0)" ::: "memory"); \
    for (int d = 0; d < 4; ++d) for (int r = 0; r < 16; ++r) o[d][r] *= al_l[crow(r, hi)]; } } while (0)
  f32x16 pA0, pA1, pB0, pB1; float mnA, mnB, alA, alB; bf16x8 pa0, pa1, pa2, pa3; const int NT = seq / KVBLK;
  constexpr int SE = 0, SO = SDEPTH - 1;
  SLOAD(SE, 0); asm volatile("s_waitcnt vmcnt(0)" ::: "memory"); SWRITE(0, SE); __syncthreads();
  qkt(pA0, pA1, K_lds, qr, r32, hi); partialSM(pA0, pA1, m_reg, mnA, alA);
  SLOAD(SO, KVBLK); if (2 < NT) SLOAD(SE, 2 * KVBLK);
  SWAIT(); SWRITE(1, SO); __syncthreads();
  for (int j = 1; j + 1 < NT; j += 2) {
    SBAR(); qkt(pB0, pB1, (bf16_t*)((char*)K_lds + SHM_K), qr, r32, hi);
    finishSM(pA0, pA1, alA, l_reg, pa0, pa1, pa2, pa3); SBAR();
    SLOAD(SO, (j + SDEPTH) * KVBLK); SBAR();
    pv_d0(o, vb0, pa0, pa1, pa2, pa3); partialSM(pB0, pB1, m_reg, mnB, alB);
    __syncthreads(); SWAIT(); SWRITE(0, SE);
    RESC(alB); __syncthreads();
    SBAR(); qkt(pA0, pA1, K_lds, qr, r32, hi);
    finishSM(pB0, pB1, alB, l_reg, pa0, pa1, pa2, pa3); SBAR();
    if (j + 3 < NT) SLOAD(SE, (j + 1 + SDEPTH) * KVBLK); SBAR();
    pv_d0(o, vb0 + (int)SHM_V, pa0, pa1, pa2, pa3); partialSM(pA0, pA1, m_reg, mnA, alA);
    __syncthreads(); SWAIT(); SWRITE(1, SO);
    RESC(alA); __syncthreads();
  }
  SBAR(); qkt(pB0, pB1, (bf16_t*)((char*)K_lds + SHM_K), qr, r32, hi);
  finishSM(pA0, pA1, alA, l_reg, pa0, pa1, pa2, pa3); SBAR();
  pv_d0(o, vb0, pa0, pa1, pa2, pa3); partialSM(pB0, pB1, m_reg, mnB, alB);
  __syncthreads(); RESC(alB);
  finishSM(pB0, pB1, alB, l_reg, pa0, pa1, pa2, pa3); SBAR();
  pv_d0(o, vb0 + (int)SHM_V, pa0, pa1, pa2, pa3);
  if (hi == 0) li_l[r32] = l_reg; asm volatile("s_waitcnt lgkmcnt(0)" ::: "memory");
  float rli[16];
#pragma unroll
  for (int r = 0; r < 16; ++r) rli[r] = __builtin_amdgcn_rcpf(li_l[crow(r, hi)]);
  bf16_t* Ow = Ob + (long)(wid * QBLK) * LDO;
#pragma unroll
  for (int r = 0; r < 16; ++r) { int orow = crow(r, hi);
#pragma unroll
    for (int d0 = 0; d0 < 4; ++d0) Ow[(long)orow * LDO + d0 * 32 + r32] = f2bf(o[d0][r] * rli[r]); }
  asm volatile("s_waitcnt vmcnt(0)" ::: "memory");
  __syncthreads();
#undef SLOAD
#undef SWRITE
#undef SWAIT
#undef RESC
}
}

namespace mk {
using att::bf16x8; using att::f32x16; using att::u32x4; using att::bf16_t; using att::crow; using att::f2bf; using att::bf2f; using att::cvtpk;
typedef float f32x4 __attribute__((ext_vector_type(4)));
typedef unsigned u32x2 __attribute__((ext_vector_type(2)));
#define LAS __attribute__((address_space(3)))
constexpr int NWAVES = 8, NTHR = 512;
constexpr int DM = 2048, MTOK = 32768, MPROMPT = 16384, SEQP = 4096, SEQS = 16384;
constexpr int DIN = 4640, DINP = 4864, DFF = 5632, DPLE = 256;
constexpr float EPS = 1e-6f;
constexpr size_t MiB = 1u << 20;
constexpr size_t WS_ROPE = 0, WS_DEC = 1 * MiB;
constexpr size_t WS_WIN = 2 * MiB, WS_WOUT = 21 * MiB, WS_WGU = 29 * MiB, WS_WDN = 73 * MiB, WS_WPG = 95 * MiB, WS_WPP = 103 * MiB, WS_PB = 104 * MiB;
constexpr size_t WS_MIX = 120 * MiB, WS_KA = 248 * MiB, WS_VA = 264 * MiB, WS_QG = 280 * MiB, WS_KG = 312 * MiB, WS_VG = 344 * MiB, WS_LR = 408 * MiB, WS_ST = 412 * MiB;
constexpr size_t WS_M1 = 248 * MiB, WS_XN = 376 * MiB, WS_HFF = 120 * MiB, WS_M3 = 120 * MiB, WS_END = 504 * MiB;
constexpr size_t DO_H = 0, DO_QF = 0, DO_QB = 32 * MiB, DO_KF = 64 * MiB, DO_KB = 96 * MiB, DO_SUM = 128 * MiB;
constexpr int LDS_BYTES = 147456;

struct Args { const float* in[23]; float* out; unsigned char* ws; int ph_lo, ph_hi; };
enum { I_XP = 0, I_XS, I_PP, I_PS, I_GPRE, I_WIN, I_GQ, I_GK, I_WGF, I_BGF, I_WGB, I_BGB, I_GGLA, I_WOUT, I_GPOSTMIX, I_GPREFFN, I_WGU, I_WDN, I_GPOSTFFN, I_GPLEPRE, I_WPG, I_WPP, I_GPLEPOST };

__device__ __forceinline__ float wave_sum(float v) {
#pragma unroll
    for (int o = 1; o < 64; o <<= 1) v += __shfl_xor(v, o);
    return v;
}
__device__ __forceinline__ unsigned pk2(float lo, float hi) { return cvtpk(lo, hi); }
__device__ __forceinline__ const float* xrow_in(const Args& a, int m) { return m < MPROMPT ? a.in[I_XP] + (size_t)m * DM : a.in[I_XS] + (size_t)(m - MPROMPT) * DM; }

template <int MODE>
__device__ __forceinline__ void p0_transpose_item(const float* W, int K, int N, bf16_t* WT, LAS float* scr, int item, int lane) {
    const int nblk = N / 32, kb = item / nblk, nb = item % nblk, k0 = 64 * kb, n0 = 32 * nb;
    int row0 = n0;
    if (MODE == 1) { if (n0 < DFF) row0 = (n0 >> 7) * 256 + (n0 & 127); else { const int n1 = n0 - DFF; row0 = (n1 >> 7) * 256 + 128 + (n1 & 127); } }
#pragma unroll 8
    for (int i = 0; i < 32; ++i) { const int kk = 2 * i + (lane >> 5); scr[kk * 33 + (lane & 31)] = W[(size_t)(k0 + kk) * N + n0 + (lane & 31)]; }
    asm volatile("s_waitcnt lgkmcnt(0)" ::: "memory");
    const int c = lane & 7;
#pragma unroll
    for (int j = 0; j < 4; ++j) { const int n = (lane >> 3) + 8 * j; const LAS float* s = scr + (8 * c) * 33 + n;
        u32x4 o; o.x = pk2(s[0 * 33], s[1 * 33]); o.y = pk2(s[2 * 33], s[3 * 33]); o.z = pk2(s[4 * 33], s[5 * 33]); o.w = pk2(s[6 * 33], s[7 * 33]);
        *(u32x4*)(WT + (size_t)(row0 + n) * K + k0 + 8 * c) = o; }
    asm volatile("s_waitcnt lgkmcnt(0)" ::: "memory");
}
__device__ __forceinline__ void p0_prologue(const Args& a, unsigned char* lds, int G) {
    unsigned char* ws = a.ws;
    const int tid = threadIdx.x, lane = tid & 63, wave = tid >> 6;
    LAS float* scr = (LAS float*)((LAS unsigned char*)lds + wave * 16384);
    const int gw = blockIdx.x * NWAVES + wave, NGW = G * NWAVES;
    constexpr int I_IN = (DM / 64) * (DIN / 32), I_OUT = (DM / 64) * (DM / 32), I_GU = (DM / 64) * (2 * DFF / 32), I_DN = (DFF / 64) * (DM / 32), I_PG = I_OUT, I_PPJ = (DPLE / 64) * (DM / 32);
    constexpr int NITEMS = I_IN + I_OUT + I_GU + I_DN + I_PG + I_PPJ;
    for (int it = gw; it < NITEMS; it += NGW) {
        int r = it;
        if (r < I_IN) { p0_transpose_item<0>(a.in[I_WIN], DM, DIN, (bf16_t*)(ws + WS_WIN), scr, r, lane); continue; } r -= I_IN;
        if (r < I_OUT) { p0_transpose_item<0>(a.in[I_WOUT], DM, DM, (bf16_t*)(ws + WS_WOUT), scr, r, lane); continue; } r -= I_OUT;
        if (r < I_GU) { p0_transpose_item<1>(a.in[I_WGU], DM, 2 * DFF, (bf16_t*)(ws + WS_WGU), scr, r, lane); continue; } r -= I_GU;
        if (r < I_DN) { p0_transpose_item<0>(a.in[I_WDN], DFF, DM, (bf16_t*)(ws + WS_WDN), scr, r, lane); continue; } r -= I_DN;
        if (r < I_PG) { p0_transpose_item<0>(a.in[I_WPG], DM, DM, (bf16_t*)(ws + WS_WPG), scr, r, lane); continue; } r -= I_PG;
        p0_transpose_item<0>(a.in[I_WPP], DPLE, DM, (bf16_t*)(ws + WS_WPP), scr, r, lane);
    }
    { bf16_t* wt = (bf16_t*)(ws + WS_WIN) + (size_t)DIN * DM; const size_t n16 = (size_t)(DINP - DIN) * DM / 8;
      for (size_t i = (size_t)blockIdx.x * NTHR + tid; i < n16; i += (size_t)G * NTHR) ((u32x4*)wt)[i] = (u32x4){0u, 0u, 0u, 0u}; }
    { bf16_t* H = (bf16_t*)((unsigned char*)a.out + DO_H); const float* g = a.in[I_GPRE];
      for (int m = gw; m < MTOK; m += NGW) {
        const f32x4* xr = (const f32x4*)xrow_in(a, m) + lane; f32x4 v[8]; float s = 0.f;
#pragma unroll
        for (int j = 0; j < 8; ++j) { v[j] = xr[64 * j]; s += (v[j].x * v[j].x + v[j].y * v[j].y) + (v[j].z * v[j].z + v[j].w * v[j].w); }
        const float rstd = __builtin_amdgcn_rsqf(wave_sum(s) * (1.f / DM) + EPS);
        u32x2* o8 = (u32x2*)(H + (size_t)m * DM) + lane;
#pragma unroll
        for (int j = 0; j < 8; ++j) { const f32x4 gg = ((const f32x4*)g)[lane + 64 * j]; u32x2 w; w.x = pk2(v[j].x * rstd * gg.x, v[j].y * rstd * gg.y); w.y = pk2(v[j].z * rstd * gg.z, v[j].w * rstd * gg.w); o8[64 * j] = w; }
      } }
    { bf16_t* PB = (bf16_t*)(ws + WS_PB); const size_t nhalf = (size_t)MPROMPT * DPLE / 8;
      for (size_t i = (size_t)blockIdx.x * NTHR + tid; i < 2 * nhalf; i += (size_t)G * NTHR) {
        const float* src = (i < nhalf) ? a.in[I_PP] + i * 8 : a.in[I_PS] + (i - nhalf) * 8;
        const f32x4 x0 = *(const f32x4*)src, x1 = *(const f32x4*)(src + 4);
        u32x4 w; w.x = pk2(x0.x, x0.y); w.y = pk2(x0.z, x0.w); w.z = pk2(x1.x, x1.y); w.w = pk2(x1.z, x1.w); ((u32x4*)PB)[i] = w; } }
    { float* ct = (float*)(ws + WS_ROPE); float* st = ct + 256 * 32;
      for (int i = blockIdx.x * NTHR + tid; i < 256 * 32; i += G * NTHR) {
        const int pos = i >> 5, fi = i & 31;
        const float freq = __builtin_amdgcn_exp2f(-(float)(2 * fi) * (13.287712379549449f / 64.0f));
        const float ang = (float)pos * freq;
        const double rev = (double)ang * 0.15915494309189535; const float fr = (float)(rev - __builtin_floor(rev));
        ct[i] = __builtin_amdgcn_cosf(fr); st[i] = __builtin_amdgcn_sinf(fr); } }
}

__device__ __forceinline__ void qk_norm_rope(const Args& a, int G) {
    unsigned char* ws = a.ws;
    const int tid = threadIdx.x, lane = tid & 63, wave = tid >> 6, sub = lane >> 4, l16 = lane & 15;
    const int gw = blockIdx.x * NWAVES + wave, NGW = G * NWAVES;
    bf16_t* MIX = (bf16_t*)(ws + WS_MIX); bf16_t* KA = (bf16_t*)(ws + WS_KA);
    const float* ct = (const float*)(ws + WS_ROPE); const float* st = ct + 256 * 32;
    const int NIT = MTOK * 10 / 4;
    for (int it = gw; it < NIT; it += NGW) {
        const int idx = it * 4 + sub, tok = idx / 10, hh = idx - tok * 10;
        bf16_t* p = (hh < 8) ? MIX + (size_t)tok * 2048 + hh * 128 + l16 * 8 : KA + (size_t)tok * 256 + (hh - 8) * 128 + l16 * 8;
        const float* g = ((hh < 8) ? a.in[I_GQ] : a.in[I_GK]) + l16 * 8;
        const u32x4 w = *(const u32x4*)p;
        float x[8] = {pg8::bf_lo(w.x), pg8::bf_hi(w.x), pg8::bf_lo(w.y), pg8::bf_hi(w.y), pg8::bf_lo(w.z), pg8::bf_hi(w.z), pg8::bf_lo(w.w), pg8::bf_hi(w.w)};
        float s = 0.f;
#pragma unroll
        for (int e = 0; e < 8; ++e) s += x[e] * x[e];
        s += __shfl_xor(s, 1); s += __shfl_xor(s, 2); s += __shfl_xor(s, 4); s += __shfl_xor(s, 8);
        const float rstd = __builtin_amdgcn_rsqf(s * (1.f / 128.f) + EPS);
        const f32x4 g0 = *(const f32x4*)g, g1 = *(const f32x4*)(g + 4);
        const float gg[8] = {g0.x, g0.y, g0.z, g0.w, g1.x, g1.y, g1.z, g1.w};
#pragma unroll
        for (int e = 0; e < 8; ++e) x[e] *= rstd * gg[e];
        const int spos = tok < MPROMPT ? (tok & (SEQP - 1)) : tok - MPROMPT;
        const int e0 = l16 * 8, part = e0 >> 6, i0 = e0 & 63, pos = part ? (spos & 63) : (spos >> 6), fi = i0 & 31;
        float y[8];
#pragma unroll
        for (int e = 0; e < 8; ++e) y[e] = __shfl_xor(x[e], 4);
        const f32x4 c0 = *(const f32x4*)(ct + pos * 32 + fi), c1 = *(const f32x4*)(ct + pos * 32 + fi + 4), s0 = *(const f32x4*)(st + pos * 32 + fi), s1 = *(const f32x4*)(st + pos * 32 + fi + 4);
        const float cc[8] = {c0.x, c0.y, c0.z, c0.w, c1.x, c1.y, c1.z, c1.w}, ss[8] = {s0.x, s0.y, s0.z, s0.w, s1.x, s1.y, s1.z, s1.w};
        const float sgn = (i0 < 32) ? -1.f : 1.f;
        float r[8];
#pragma unroll
        for (int e = 0; e < 8; ++e) r[e] = x[e] * cc[e] + sgn * y[e] * ss[e];
        u32x4 o; o.x = pk2(r[0], r[1]); o.y = pk2(r[2], r[3]); o.z = pk2(r[4], r[5]); o.w = pk2(r[6], r[7]);
        *(u32x4*)p = o;
    }
}

__device__ __forceinline__ float logsig16(float z) { return (fminf(z, 0.f) - __logf(1.0f + __expf(-fabsf(z)))) * (1.0f / 16.0f); }

__device__ __forceinline__ void g1_unit(const Args& a, char* lds, int scg, int h) {
    unsigned char* ws = a.ws; unsigned char* dob = (unsigned char*)a.out;
    const int tid = threadIdx.x, wid = tid >> 6, lane = tid & 63, r32 = lane & 31, hi = lane >> 5;
    const int d = tid & 127, qtr = tid >> 7;
    constexpr int KT_PITCH = 528;
    char* kT = lds; char* Vs = lds + 67584; float* LRs = (float*)(lds + 100352); float* qsum = (float*)(lds + 116736); float* dtot = (float*)(lds + 118784);
    const long tok0 = (long)scg * 256;
    const bf16_t* QG = (const bf16_t*)(ws + WS_QG); const bf16_t* KG = (const bf16_t*)(ws + WS_KG); const bf16_t* VG = (const bf16_t*)(ws + WS_VG);
    const float* LR = (const float*)(ws + WS_LR);
    const int sr = tid >> 4, sc = (tid & 15) * 8, vst0 = att::v_st(sr, sc), vst1 = att::v_st(32 + sr, sc);
    for (int dir = 0; dir < 2; ++dir) {
        bf16_t* QX = (bf16_t*)(dob + (dir ? DO_QB : DO_QF)); bf16_t* KX = (bf16_t*)(dob + (dir ? DO_KB : DO_KF));
        const float* wup = a.in[dir ? I_WGB : I_WGF]; const float* bup = a.in[dir ? I_BGB : I_BGF];
        __syncthreads();
        { const int t = tid >> 1, hf = tid & 1; const float* src = LR + (tok0 + t) * 32 + dir * 16 + hf * 8;
          *(f32x4*)(LRs + t * 16 + hf * 8) = *(const f32x4*)src; *(f32x4*)(LRs + t * 16 + hf * 8 + 4) = *(const f32x4*)(src + 4); }
        float w[16];
#pragma unroll
        for (int r = 0; r < 16; ++r) w[r] = wup[r * 512 + h * 128 + d];
        const float bias = bup[h * 128 + d];
        __syncthreads();
        float run = 0.f;
#pragma unroll 2
        for (int i = 0; i < 64; ++i) { const float* lr = LRs + (qtr * 64 + i) * 16; float z = bias;
#pragma unroll
            for (int r = 0; r < 16; ++r) z = fmaf(lr[r], w[r], z);
            run += logsig16(z); }
        qsum[qtr * 128 + d] = run;
        __syncthreads();
        const float q0 = qsum[d], q1 = qsum[128 + d], q2 = qsum[256 + d], q3 = qsum[384 + d];
        const float tot = (q0 + q1) + (q2 + q3);
        if (qtr == 0) dtot[d] = __expf(tot);
        float before = (qtr > 0 ? q0 : 0.f) + (qtr > 1 ? q1 : 0.f) + (qtr > 2 ? q2 : 0.f);
        float acc = dir ? (tot - before) : before;
        for (int i8 = 0; i8 < 64; i8 += 8) {
            unsigned pk[4];
#pragma unroll
            for (int ii = 0; ii < 8; ++ii) {
                const int i = i8 + ii; const long tok = tok0 + qtr * 64 + i;
                const float* lr = LRs + (qtr * 64 + i) * 16; float z = bias;
#pragma unroll
                for (int r = 0; r < 16; ++r) z = fmaf(lr[r], w[r], z);
                const float l = logsig16(z); float B;
                if (dir == 0) { acc += l; B = acc; } else { B = acc; acc -= l; }
                B = fmaxf(B, -80.f);
                const float e = __expf(B), ei = __expf(-B);
                const size_t off = (size_t)tok * 512 + h * 128 + d;
                const float qv = bf2f(QG[off]) * (0.088388347648318440f * e), kv = bf2f(KG[off]) * ei;
                QX[off] = f2bf(qv); const bf16_t kb = f2bf(kv); KX[off] = kb;
                if (ii & 1) pk[ii >> 1] |= (unsigned)kb << 16; else pk[ii >> 1] = kb;
            }
            *(u32x4*)(kT + d * KT_PITCH + (qtr * 64 + i8) * 2) = (u32x4){pk[0], pk[1], pk[2], pk[3]};
        }
        const int db = wid & 3, vh = wid >> 2;
        f32x16 c[4] = {};
        const int vb = (int)(uintptr_t)Vs + vh * 16384 + att::v_rd_base(lane);
        for (int tile = 0; tile < 4; ++tile) {
            const bf16_t* vp = VG + (size_t)(tok0 + tile * 64 + sr) * 1024 + h * 256 + sc;
            const bf16x8 v0 = *(const bf16x8*)vp, v1 = *(const bf16x8*)(vp + 32 * 1024), v2 = *(const bf16x8*)(vp + 128), v3 = *(const bf16x8*)(vp + 32 * 1024 + 128);
            __syncthreads();
            *(bf16x8*)(Vs + vst0) = v0; *(bf16x8*)(Vs + vst1) = v1; *(bf16x8*)(Vs + 16384 + vst0) = v2; *(bf16x8*)(Vs + 16384 + vst1) = v3;
            __syncthreads();
            const char* kr = kT + (db * 32 + r32) * KT_PITCH + (tile * 64 + hi * 8) * 2;
            const bf16x8 a0 = *(const bf16x8*)(kr), a1 = *(const bf16x8*)(kr + 32), a2 = *(const bf16x8*)(kr + 64), a3 = *(const bf16x8*)(kr + 96);
            att::pv_d0(c, vb, a0, a1, a2, a3);
        }
        const size_t sidx = ((size_t)(scg * 4 + h) * 2 + dir);
        float* SUM = (float*)(dob + DO_SUM) + sidx * 32768;
#pragma unroll
        for (int r = 0; r < 16; ++r) { const int row = db * 32 + crow(r, hi); const float dt = dtot[row];
#pragma unroll
            for (int d0 = 0; d0 < 4; ++d0) SUM[row * 256 + vh * 128 + d0 * 32 + r32] = c[d0][r] * dt; }
        if (qtr == 0) ((float*)(ws + WS_DEC))[sidx * 128 + d] = dtot[d];
    }
    __syncthreads();
}

__device__ __forceinline__ void g2_scan(const Args& a, int G) {
    unsigned char* ws = a.ws; unsigned char* dob = (unsigned char*)a.out;
    const f32x4* SUM4 = (const f32x4*)(dob + DO_SUM); const float* DEC = (const float*)(ws + WS_DEC); u32x2* ST2 = (u32x2*)(ws + WS_ST);
    for (int item = blockIdx.x * NTHR + threadIdx.x; item < 40 * 8192; item += G * NTHR) {
        const int c = item >> 13, e4 = item & 8191, dir = c & 1, h = (c >> 1) & 3, seq = c >> 3;
        const int nsc = seq < 4 ? 16 : 64, scbase = seq < 4 ? seq * 16 : 64, dd = e4 >> 6;
        f32x4 S = {0.f, 0.f, 0.f, 0.f};
        for (int i = 0; i < nsc; ++i) {
            const int sc = dir ? scbase + nsc - 1 - i : scbase + i;
            const size_t idx = (size_t)(sc * 4 + h) * 2 + dir;
            u32x2 w; w.x = pk2(S.x, S.y); w.y = pk2(S.z, S.w); ST2[idx * 8192 + e4] = w;
            const float dec = DEC[idx * 128 + dd]; const f32x4 kv = SUM4[idx * 8192 + e4];
            S = S * dec + kv;
        }
    }
}

__device__ __forceinline__ void g3_unit(const Args& a, char* lds, int scg, int h, int rh) {
    unsigned char* ws = a.ws; unsigned char* dob = (unsigned char*)a.out;
    const int tid = threadIdx.x, wid = tid >> 6, lane = tid & 63, r32 = lane & 31, hi = lane >> 5;
    const int rg = wid & 3, vh = wid >> 2;
    bf16_t* KFs = (bf16_t*)lds; bf16_t* KBs = (bf16_t*)(lds + 16384); char* Vs = lds + 32768; float* xs = (float*)(lds + 65536);
    const bf16_t* QF = (const bf16_t*)(dob + DO_QF); const bf16_t* QB = (const bf16_t*)(dob + DO_QB); const bf16_t* KF = (const bf16_t*)(dob + DO_KF); const bf16_t* KB = (const bf16_t*)(dob + DO_KB);
    const bf16_t* VG = (const bf16_t*)(ws + WS_VG); const bf16_t* ST = (const bf16_t*)(ws + WS_ST); bf16_t* MIX = (bf16_t*)(ws + WS_MIX);
    const long tok0 = (long)scg * 256; const int qlo = rh * 128 + rg * 32;
    const size_t qo = (size_t)(tok0 + qlo + r32) * 512 + h * 128 + hi * 8;
#define G3_LDQ(QX, SRC) do { _Pragma("unroll") for (int d0 = 0; d0 < 8; ++d0) QX[d0] = *(const bf16x8*)((SRC) + qo + d0 * 16); } while (0)
    f32x16 o[4] = {};
    const int sr = tid >> 4, sc = (tid & 15) * 8, vst0 = att::v_st(sr, sc), vst1 = att::v_st(32 + sr, sc);
    const int vb = (int)(uintptr_t)Vs + vh * 16384 + att::v_rd_base(lane);
#define G3_INTER(DIR, DT, QX) do { const bf16_t* Sg = ST + (((size_t)(scg * 4 + h) * 2 + (DIR)) * 128 + (DT) * 64 + sr) * 256 + sc; \
        const bf16x8 s0 = *(const bf16x8*)Sg, s1 = *(const bf16x8*)(Sg + 32 * 256), s2 = *(const bf16x8*)(Sg + 128), s3 = *(const bf16x8*)(Sg + 32 * 256 + 128); \
        __syncthreads(); \
        *(bf16x8*)(Vs + vst0) = s0; *(bf16x8*)(Vs + vst1) = s1; *(bf16x8*)(Vs + 16384 + vst0) = s2; *(bf16x8*)(Vs + 16384 + vst1) = s3; \
        __syncthreads(); \
        att::pv_d0(o, vb, QX[4 * (DT) + 0], QX[4 * (DT) + 1], QX[4 * (DT) + 2], QX[4 * (DT) + 3]); } while (0)
    { bf16x8 qx[8]; G3_LDQ(qx, QF); G3_INTER(0, 0, qx); G3_INTER(0, 1, qx); }
    { bf16x8 qx[8]; G3_LDQ(qx, QB); G3_INTER(1, 0, qx); G3_INTER(1, 1, qx); }
#undef G3_INTER
    const int iq = qlo + r32;
    for (int J = 0; J < 4; ++J) {
        const long k0 = tok0 + 64 * J;
        const size_t ko = (size_t)(k0 + sr) * 512 + h * 128 + sc;
        const bf16x8 f0 = *(const bf16x8*)(KF + ko), f1 = *(const bf16x8*)(KF + ko + 32 * 512), b0 = *(const bf16x8*)(KB + ko), b1 = *(const bf16x8*)(KB + ko + 32 * 512);
        const bf16_t* vp = VG + (size_t)(k0 + sr) * 1024 + h * 256 + sc;
        const bf16x8 v0 = *(const bf16x8*)vp, v1 = *(const bf16x8*)(vp + 32 * 1024), v2 = *(const bf16x8*)(vp + 128), v3 = *(const bf16x8*)(vp + 32 * 1024 + 128);
        __syncthreads();
        { const int kc = sc * 2;
          *(bf16x8*)((char*)KFs + KSWZ(sr, kc)) = f0; *(bf16x8*)((char*)KFs + KSWZ(32 + sr, kc)) = f1; *(bf16x8*)((char*)KBs + KSWZ(sr, kc)) = b0; *(bf16x8*)((char*)KBs + KSWZ(32 + sr, kc)) = b1; }
        *(bf16x8*)(Vs + vst0) = v0; *(bf16x8*)(Vs + vst1) = v1; *(bf16x8*)(Vs + 16384 + vst0) = v2; *(bf16x8*)(Vs + 16384 + vst1) = v3;
        __syncthreads();
        const int klo = 64 * J;
        const bool needF = (klo <= qlo + 31), needB = (klo + 63 > qlo);
        f32x16 pF0, pF1, pB0, pB1;
        if (needF) { bf16x8 qx[8]; G3_LDQ(qx, QF); att::qkt(pF0, pF1, KFs, qx, r32, hi); } else { pF0 = f32x16{}; pF1 = f32x16{}; }
        if (needB) { bf16x8 qx[8]; G3_LDQ(qx, QB); att::qkt(pB0, pB1, KBs, qx, r32, hi); } else { pB0 = f32x16{}; pB1 = f32x16{}; }
#pragma unroll
        for (int r = 0; r < 16; ++r) { const int j0 = klo + crow(r, hi); pF0[r] = (j0 <= iq) ? pF0[r] : pB0[r]; pF1[r] = (j0 + 32 <= iq) ? pF1[r] : pB1[r]; }
        bf16x8 pa0, pa1, pa2, pa3;
        PK4(pF0, 0, pa0); PK4(pF0, 8, pa1); PK4(pF1, 0, pa2); PK4(pF1, 8, pa3);
        att::pv_d0(o, vb, pa0, pa1, pa2, pa3);
    }
    float ss[16];
#pragma unroll
    for (int r = 0; r < 16; ++r) { float s = 0.f;
#pragma unroll
        for (int d0 = 0; d0 < 4; ++d0) s += o[d0][r] * o[d0][r];
        s += __shfl_xor(s, 1); s += __shfl_xor(s, 2); s += __shfl_xor(s, 4); s += __shfl_xor(s, 8); s += __shfl_xor(s, 16); ss[r] = s; }
    if (r32 == 0) {
#pragma unroll
        for (int r = 0; r < 16; ++r) xs[vh * 128 + rg * 32 + crow(r, hi)] = ss[r]; }
    __syncthreads();
    const float* gn = a.in[I_GGLA];
    float gcol[4];
#pragma unroll
    for (int d0 = 0; d0 < 4; ++d0) gcol[d0] = gn[vh * 128 + d0 * 32 + r32];
#pragma unroll
    for (int r = 0; r < 16; ++r) { const int rr = rg * 32 + crow(r, hi);
        const float rstd = __builtin_amdgcn_rsqf((xs[rr] + xs[128 + rr]) * (1.f / 256.f) + EPS);
        bf16_t* mp = MIX + (size_t)(tok0 + rh * 128 + rr) * 2048 + 1024 + h * 256 + vh * 128 + r32;
#pragma unroll
        for (int d0 = 0; d0 < 4; ++d0) { const float gt = bf2f(mp[d0 * 32]); const float y = o[d0][r] * rstd * gcol[d0] * gt * __builtin_amdgcn_rcpf(1.0f + __expf(-gt)); mp[d0 * 32] = f2bf(y); } }
    __syncthreads();
}

template <bool FROM_IN, bool HAS_XN>
__device__ __forceinline__ void row_pass(const Args& a, int G, const bf16_t* Mb, const float* g1, const float* g2, bf16_t* XN) {
    const int tid = threadIdx.x, lane = tid & 63, wave = tid >> 6;
    const int gw = blockIdx.x * NWAVES + wave, NGW = G * NWAVES;
    for (int m = gw; m < MTOK; m += NGW) {
        const float* xi = FROM_IN ? xrow_in(a, m) : a.out + (size_t)m * DM; float* xo = a.out + (size_t)m * DM;
        float mv[4][8], xv[4][8]; float s = 0.f;
#pragma unroll
        for (int j = 0; j < 4; ++j) { const int c = (lane + 64 * j) * 8; const u32x4 w = *(const u32x4*)(Mb + (size_t)m * DM + c);
            mv[j][0] = pg8::bf_lo(w.x); mv[j][1] = pg8::bf_hi(w.x); mv[j][2] = pg8::bf_lo(w.y); mv[j][3] = pg8::bf_hi(w.y); mv[j][4] = pg8::bf_lo(w.z); mv[j][5] = pg8::bf_hi(w.z); mv[j][6] = pg8::bf_lo(w.w); mv[j][7] = pg8::bf_hi(w.w);
            const f32x4 x0 = *(const f32x4*)(xi + c), x1 = *(const f32x4*)(xi + c + 4);
            xv[j][0] = x0.x; xv[j][1] = x0.y; xv[j][2] = x0.z; xv[j][3] = x0.w; xv[j][4] = x1.x; xv[j][5] = x1.y; xv[j][6] = x1.z; xv[j][7] = x1.w;
#pragma unroll
            for (int e = 0; e < 8; ++e) s += mv[j][e] * mv[j][e]; }
        const float rstd = __builtin_amdgcn_rsqf(wave_sum(s) * (1.f / DM) + EPS);
        float s2 = 0.f;
#pragma unroll
        for (int j = 0; j < 4; ++j) { const int c = (lane + 64 * j) * 8; const f32x4 ga = *(const f32x4*)(g1 + c), gb = *(const f32x4*)(g1 + c + 4);
            const float gg[8] = {ga.x, ga.y, ga.z, ga.w, gb.x, gb.y, gb.z, gb.w};
#pragma unroll
            for (int e = 0; e < 8; ++e) { xv[j][e] += mv[j][e] * rstd * gg[e]; s2 += xv[j][e] * xv[j][e]; }
            *(f32x4*)(xo + c) = (f32x4){xv[j][0], xv[j][1], xv[j][2], xv[j][3]}; *(f32x4*)(xo + c + 4) = (f32x4){xv[j][4], xv[j][5], xv[j][6], xv[j][7]}; }
        if (HAS_XN) {
            const float rstd2 = __builtin_amdgcn_rsqf(wave_sum(s2) * (1.f / DM) + EPS);
#pragma unroll
            for (int j = 0; j < 4; ++j) { const int c = (lane + 64 * j) * 8; const f32x4 ga = *(const f32x4*)(g2 + c), gb = *(const f32x4*)(g2 + c + 4);
                u32x4 w; w.x = pk2(xv[j][0] * rstd2 * ga.x, xv[j][1] * rstd2 * ga.y); w.y = pk2(xv[j][2] * rstd2 * ga.z, xv[j][3] * rstd2 * ga.w);
                w.z = pk2(xv[j][4] * rstd2 * gb.x, xv[j][5] * rstd2 * gb.y); w.w = pk2(xv[j][6] * rstd2 * gb.z, xv[j][7] * rstd2 * gb.w);
                *(u32x4*)(XN + (size_t)m * DM + c) = w; }
        }
    }
}

__device__ __forceinline__ void att_item(const Args& a, char* lds, int i) {
    unsigned char* ws = a.ws;
    const int k = i >> 8, c = i & 255, xcd = c & 7, j = c >> 3;
    bf16_t* MIX = (bf16_t*)(ws + WS_MIX); const bf16_t* KA = (const bf16_t*)(ws + WS_KA); const bf16_t* VA = (const bf16_t*)(ws + WS_VA);
    int kvh, qh, qb, seq; size_t t0;
    if (k < 2) { kvh = xcd >> 2; const int ii = (xcd & 3) * 64 + j * 2 + k; qh = kvh * 4 + (ii >> 6); qb = ii & 63; t0 = (size_t)MPROMPT; seq = SEQS; }
    else { const int b = xcd >> 1; kvh = xcd & 1; const int ii = j * 2 + (k - 2); qh = kvh * 4 + (ii >> 4); qb = ii & 15; t0 = (size_t)b * SEQP; seq = SEQP; }
    bf16_t* qp = MIX + (t0 + (size_t)qb * 256) * 2048 + qh * 128;
    att::attn_dense_body<2048, 256, 2048>(qp, KA + t0 * 256 + kvh * 128, VA + t0 * 256 + kvh * 128, qp, seq, lds);
}

template <class Epi>
__device__ __forceinline__ void run_gemm(char* lds, const bf16_t* A, const bf16_t* Bt, int M, int N, int K, int G, const Epi& E) {
    pg8::Gemm g{A, Bt, M, N, K}; pg8::StaticOrder S; S.init(M, N, G, (int)blockIdx.x);
    pg8::gemm_phase<Epi, pg8::StaticOrder, true, true>((PG8_LAS unsigned char*)lds, g, S, E);
}

__global__ void __launch_bounds__(NTHR, 2) mk_fwd(Args a) {
    extern __shared__ __attribute__((aligned(16))) unsigned char lds_raw[];
    char* lds = (char*)lds_raw;
    const int G = gridDim.x, lo = a.ph_lo, hi = a.ph_hi;
    unsigned char* ws = a.ws; unsigned char* dob = (unsigned char*)a.out;
    cg::grid_group grid = cg::this_grid();
#ifndef PHMASK
#define PHMASK 0xFFFF
#endif
#define IN(k) ((((PHMASK) >> (k)) & 1) && lo <= (k) && (k) < hi)
#define SEAM(k) do { if (IN(k) && IN((k) + 1)) grid.sync(); } while (0)
    if (IN(0)) { p0_prologue(a, lds_raw, G); } SEAM(0);
    if (IN(1)) { pg8::EpiSplit E{(bf16_t*)(ws + WS_MIX), (bf16_t*)(ws + WS_KA), (bf16_t*)(ws + WS_VA), (bf16_t*)(ws + WS_QG), (bf16_t*)(ws + WS_KG), (bf16_t*)(ws + WS_VG), (float*)(ws + WS_LR)};
        run_gemm(lds, (const bf16_t*)(dob + DO_H), (const bf16_t*)(ws + WS_WIN), MTOK, DINP, DM, G, E); } SEAM(1);
    if (IN(2)) { qk_norm_rope(a, G); for (int u = blockIdx.x; u < 512; u += G) g1_unit(a, lds, u >> 2, u & 3); } SEAM(2);
    if (IN(3)) { g2_scan(a, G); } SEAM(3);
    if (IN(4)) {
#ifndef NO_ATT
        for (int i = blockIdx.x; i < 1024; i += G) att_item(a, lds, i);
#endif
        asm volatile("" ::: "memory");
#ifndef NO_G3
        for (int g = blockIdx.x; g < 1024; g += G) g3_unit(a, lds, g >> 3, (g >> 1) & 3, g & 1);
#endif
    } SEAM(4);
    if (IN(5)) { pg8::EpiPlain E{(bf16_t*)(ws + WS_M1), DM}; run_gemm(lds, (const bf16_t*)(ws + WS_MIX), (const bf16_t*)(ws + WS_WOUT), MTOK, DM, DM, G, E); } SEAM(5);
    if (IN(6)) { row_pass<true, true>(a, G, (const bf16_t*)(ws + WS_M1), a.in[I_GPOSTMIX], a.in[I_GPREFFN], (bf16_t*)(ws + WS_XN)); } SEAM(6);
#pragma unroll
    for (int half = 0; half < 2; ++half) {
        const size_t roff = (size_t)half * (MTOK / 2) * DM;
        if (IN(7 + 2 * half)) { pg8::EpiSwiGLU E{(bf16_t*)(ws + WS_HFF), DFF}; run_gemm(lds, (const bf16_t*)(ws + WS_XN) + roff, (const bf16_t*)(ws + WS_WGU), MTOK / 2, 2 * DFF, DM, G, E); } SEAM(7 + 2 * half);
        if (IN(8 + 2 * half)) { pg8::EpiPlain E{(bf16_t*)(ws + WS_XN) + roff, DM}; run_gemm(lds, (const bf16_t*)(ws + WS_HFF), (const bf16_t*)(ws + WS_WDN), MTOK / 2, DM, DFF, G, E); } SEAM(8 + 2 * half);
    }
    if (IN(11)) { row_pass<false, true>(a, G, (const bf16_t*)(ws + WS_XN), a.in[I_GPOSTFFN], a.in[I_GPLEPRE], (bf16_t*)(ws + WS_XN)); } SEAM(11);
    if (IN(12)) { pg8::EpiPlain E0{(bf16_t*)(ws + WS_M3), DM}; run_gemm(lds, (const bf16_t*)(ws + WS_PB), (const bf16_t*)(ws + WS_WPP), MTOK, DM, DPLE, G, E0);
        pg8::EpiMulSig E1{(bf16_t*)(ws + WS_M3), DM}; run_gemm(lds, (const bf16_t*)(ws + WS_XN), (const bf16_t*)(ws + WS_WPG), MTOK, DM, DM, G, E1); } SEAM(12);
    if (IN(13)) { row_pass<false, false>(a, G, (const bf16_t*)(ws + WS_M3), a.in[I_GPLEPOST], nullptr, nullptr); }
#undef IN
#undef SEAM
}
constexpr int NPHASE = 14;
}

extern "C" void kernel_launch(void* const* d_in, const int* in_sizes, int n_in, void* d_out, int out_size, void* d_ws, size_t ws_size, hipStream_t stream) {
    using namespace mk;
    static int grid = 0;
    if (grid == 0) {
        if (n_in != 23 || out_size != 2 * MPROMPT * DM || ws_size < WS_END) { fprintf(stderr, "kernel_launch: unexpected shapes n_in %d out %d ws %zu\n", n_in, out_size, ws_size); grid = -1; return; }
        int dev = 0, cus = 0, per_cu = 0;
        if (hipGetDevice(&dev) != hipSuccess || hipDeviceGetAttribute(&cus, hipDeviceAttributeMultiprocessorCount, dev) != hipSuccess) { grid = -1; return; }
        if (hipFuncSetAttribute((const void*)mk_fwd, hipFuncAttributeMaxDynamicSharedMemorySize, LDS_BYTES) != hipSuccess) { fprintf(stderr, "kernel_launch: hipFuncSetAttribute failed\n"); grid = -1; return; }
        if (hipOccupancyMaxActiveBlocksPerMultiprocessor(&per_cu, (const void*)mk_fwd, NTHR, LDS_BYTES) != hipSuccess || per_cu < 1) { fprintf(stderr, "kernel_launch: occupancy query says %d\n", per_cu); per_cu = 1; }
        (void)hipGetLastError();
        grid = cus * per_cu;
    }
    if (grid < 0) return;
    Args a{};
    for (int i = 0; i < 23; ++i) a.in[i] = (const float*)d_in[i];
    a.out = (float*)d_out; a.ws = (unsigned char*)d_ws;
#if ONE_LAUNCH
    a.ph_lo = 0; a.ph_hi = NPHASE;
    void* args[] = {&a};
    hipError_t e = hipLaunchCooperativeKernel((const void*)mk_fwd, dim3(grid), dim3(NTHR), args, LDS_BYTES, stream);
    if (e != hipSuccess) fprintf(stderr, "cooperative launch failed: %s (grid %d)\n", hipGetErrorString(e), grid);
#else
    for (int p = 0; p < NPHASE; ++p) { a.ph_lo = p; a.ph_hi = p + 1; hipLaunchKernelGGL(mk_fwd, dim3(grid), dim3(NTHR), LDS_BYTES, stream, a); }
#endif
}
```

```cpp
#include <hip/hip_runtime.h>
#include <hip/hip_cooperative_groups.h>
#include <hip/hip_bf16.h>
#include <cstdio>
#include <cstdint>
namespace cg = cooperative_groups;

#ifndef ONE_LAUNCH
#define ONE_LAUNCH 1
#endif

namespace pg8 {
#define PG8_LAS __attribute__((address_space(3)))
typedef unsigned short bf16_t;
typedef short bf16x8 __attribute__((ext_vector_type(8)));
typedef float f32x4 __attribute__((ext_vector_type(4)));
typedef unsigned u32x4 __attribute__((ext_vector_type(4)));
constexpr int BM = 256, BK = 64, HALF = 128, HTB = HALF * BK * 2  , STAGE_BYTES = 8 * HTB, NXCD = 8, WGM = 8;

__host__ __device__ __forceinline__ int lds_byte(int r, int c) { const int st = (r >> 4) * 2 + (c >> 5), rr = r & 15, cc = c & 31, ob = rr * 64 + cc * 2; return st * 1024 + (ob ^ (((ob >> 9) & 1) << 5)); }
__host__ __device__ __forceinline__ void stage_rc(int b, int& R, int& C) { const int st = b / 1024, sb = b % 1024, swz = sb ^ (((sb >> 9) & 1) << 5); R = (st >> 1) * 16 + swz / 64; C = (st & 1) * 32 + (swz % 64) / 2; }
__host__ __device__ __forceinline__ int perm32(int rho) { const int n = rho >> 4, i = rho & 15; return 8 * (i >> 2) + 4 * n + (i & 3); }

struct Unit { int pm, pn; };
struct Gemm { const bf16_t* A; const bf16_t* Bt; int M, N, K; };

struct StaticOrder {
    int nM, nN, nwg, G, c;
    __host__ __device__ void init(int M, int N, int G_, int c_) { nM = M / BM; nN = N / BM; nwg = nM * nN; G = G_; c = c_; }
    __host__ __device__ bool next(int i, Unit& u) const {
        const long L = (long)i * G + c; if (L >= nwg) return false;
        int wgid = (int)L; { const int q = nwg / NXCD, r = nwg % NXCD, xcd = wgid % NXCD, off = wgid / NXCD; wgid = (xcd < r ? xcd * (q + 1) : r * (q + 1) + (xcd - r) * q) + off; }
        const int nig = WGM * nN, gid = wgid / nig, fm = gid * WGM, gsz = (nM - fm) < WGM ? (nM - fm) : WGM;
        u.pm = fm + ((wgid % nig) % gsz); u.pn = (wgid % nig) / gsz; return true;
    }
    __device__ __forceinline__ void a_ready(const Unit&) const {}
    __device__ __forceinline__ void done(const Unit&) const {}
};

__device__ __forceinline__ unsigned cvt_pk_bf16(float lo, float hi) { unsigned r; asm volatile("v_cvt_pk_bf16_f32 %0, %1, %2" : "=v"(r) : "v"(lo), "v"(hi)); return r; }

__device__ __forceinline__ u32x4 pack8(const f32x4 v0, const f32x4 v1) { u32x4 w; w.x = cvt_pk_bf16(v0[0], v0[1]); w.y = cvt_pk_bf16(v0[2], v0[3]); w.z = cvt_pk_bf16(v1[0], v1[1]); w.w = cvt_pk_bf16(v1[2], v1[3]); return w; }
__device__ __forceinline__ float bf_lo(unsigned w) { return __builtin_bit_cast(float, w << 16); }
__device__ __forceinline__ float bf_hi(unsigned w) { return __builtin_bit_cast(float, w & 0xffff0000u); }

struct EpiPlain {
    static constexpr bool PERM = true, AFTER_DRAIN = false;
    bf16_t* O; int ldc;
    __device__ __forceinline__ void operator()(const f32x4 (&acc)[2][2][4][2], const Unit& u, int wr, int wc, int fr, int fq) const {
        const int row0 = u.pm * BM + wr * 64 + fr, col0 = u.pn * BM + wc * 32 + 8 * fq;
#pragma unroll
        for (int ai = 0; ai < 2; ++ai)
#pragma unroll
            for (int m = 0; m < 4; ++m) { bf16_t* rowp = O + (size_t)(row0 + ai * HALF + m * 16) * ldc + col0;
#pragma unroll
                for (int bj = 0; bj < 2; ++bj) *(u32x4*)(rowp + bj * HALF) = pack8(acc[ai][bj][m][0], acc[ai][bj][m][1]); }
    }
};
struct EpiSplit {
    static constexpr bool PERM = true, AFTER_DRAIN = false;
    bf16_t *MIX, *KA, *VA, *QG, *KG, *VG; float* LR;
    __device__ __forceinline__ void operator()(const f32x4 (&acc)[2][2][4][2], const Unit& u, int wr, int wc, int fr, int fq) const {
        const int pn = u.pn; const int row0 = u.pm * BM + wr * 64 + fr;
        if (pn == 18) {
            if (wc == 0) {
#pragma unroll
                for (int ai = 0; ai < 2; ++ai)
#pragma unroll
                    for (int m = 0; m < 4; ++m) { float* rp = LR + (size_t)(row0 + ai * HALF + m * 16) * 32 + 8 * fq; *(f32x4*)rp = acc[ai][0][m][0]; *(f32x4*)(rp + 4) = acc[ai][0][m][1]; }
            }
            return;
        }
        bf16_t* base; int ld;
        if (pn < 4) { base = MIX + pn * 256; ld = 2048; }
        else if (pn == 4) { base = KA; ld = 256; }
        else if (pn == 5) { base = VA; ld = 256; }
        else if (pn < 8) { base = QG + (pn - 6) * 256; ld = 512; }
        else if (pn < 10) { base = KG + (pn - 8) * 256; ld = 512; }
        else if (pn < 14) { base = VG + (pn - 10) * 256; ld = 1024; }
        else { base = MIX + 1024 + (pn - 14) * 256; ld = 2048; }
        const int col0 = wc * 32 + 8 * fq;
#pragma unroll
        for (int ai = 0; ai < 2; ++ai)
#pragma unroll
            for (int m = 0; m < 4; ++m) { bf16_t* rowp = base + (size_t)(row0 + ai * HALF + m * 16) * ld + col0;
#pragma unroll
                for (int bj = 0; bj < 2; ++bj) *(u32x4*)(rowp + bj * HALF) = pack8(acc[ai][bj][m][0], acc[ai][bj][m][1]); }
    }
};
struct EpiSwiGLU {
    static constexpr bool PERM = true, AFTER_DRAIN = false;
    bf16_t* O; int ldc;
    __device__ __forceinline__ void operator()(const f32x4 (&acc)[2][2][4][2], const Unit& u, int wr, int wc, int fr, int fq) const {
        const int row0 = u.pm * BM + wr * 64 + fr, col0 = u.pn * HALF + wc * 32 + 8 * fq;
#pragma unroll
        for (int ai = 0; ai < 2; ++ai)
#pragma unroll
            for (int m = 0; m < 4; ++m) { f32x4 h[2];
#pragma unroll
                for (int n = 0; n < 2; ++n)
#pragma unroll
                    for (int e = 0; e < 4; ++e) { const float g = acc[ai][0][m][n][e], up = acc[ai][1][m][n][e]; h[n][e] = g * up * __builtin_amdgcn_rcpf(1.0f + __expf(-g)); }
                *(u32x4*)(O + (size_t)(row0 + ai * HALF + m * 16) * ldc + col0) = pack8(h[0], h[1]); }
    }
};
struct EpiMulSig {
    static constexpr bool PERM = true, AFTER_DRAIN = false;
    bf16_t* O; int ldc;
    __device__ __forceinline__ void operator()(const f32x4 (&acc)[2][2][4][2], const Unit& u, int wr, int wc, int fr, int fq) const {
        const int row0 = u.pm * BM + wr * 64 + fr, col0 = u.pn * BM + wc * 32 + 8 * fq;
#pragma unroll
        for (int ai = 0; ai < 2; ++ai)
#pragma unroll
            for (int m = 0; m < 4; ++m) { bf16_t* rowp = O + (size_t)(row0 + ai * HALF + m * 16) * ldc + col0;
#pragma unroll
                for (int bj = 0; bj < 2; ++bj) { const u32x4 p = *(const u32x4*)(rowp + bj * HALF); f32x4 v0 = acc[ai][bj][m][0], v1 = acc[ai][bj][m][1];
#pragma unroll
                    for (int e = 0; e < 4; ++e) { v0[e] = __builtin_amdgcn_rcpf(1.0f + __expf(-v0[e])); v1[e] = __builtin_amdgcn_rcpf(1.0f + __expf(-v1[e])); }
                    v0[0] *= bf_lo(p.x); v0[1] *= bf_hi(p.x); v0[2] *= bf_lo(p.y); v0[3] *= bf_hi(p.y); v1[0] *= bf_lo(p.z); v1[1] *= bf_hi(p.z); v1[2] *= bf_lo(p.w); v1[3] *= bf_hi(p.w);
                    *(u32x4*)(rowp + bj * HALF) = pack8(v0, v1); } }
    }
};
template <class Epi, class Sched, bool ALIGN_EPI = false, bool SP2 = false>
__device__ __forceinline__ void gemm_phase(PG8_LAS unsigned char* lds, const Gemm g, const Sched& S, const Epi& E) {
    int tid_o = threadIdx.x; asm volatile("" : "+v"(tid_o));
    const int tid = tid_o, wid = __builtin_amdgcn_readfirstlane(tid >> 6), lane = tid & 63, wr = wid >> 2, wc = wid & 3, fr = lane & 15, fq = lane >> 4;
    const int K = g.K, nt = K / BK;
    unsigned voffA[2], voffB[2];
#pragma unroll
    for (int i = 0; i < 2; ++i) { int R, C; stage_rc(tid * 16 + i * 8192, R, C); const int Rb = Epi::PERM ? ((R & ~31) + perm32(R & 31)) : R;
        voffA[i] = (unsigned)(R * K + C) * 2u; voffB[i] = (unsigned)(Rb * K + C) * 2u; }
    const size_t kstep = (size_t)(BK * 2);
    const size_t hstep = (size_t)HALF * K * 2;
    const size_t tstep = 2 * hstep;
    const unsigned ldsw = (unsigned)wid * 1024u;
    const int aoff = lds_byte(wr * 64 + fr, fq * 8), boff = lds_byte(wc * 32 + fr, fq * 8);
#define PG8_SA(b, h) (((b) * 2 + (h)) * HTB)
#define PG8_SB(b, h) ((4 + (b) * 2 + (h)) * HTB)
#define PG8_STAGE(bufoff, gbase, voff) do { _Pragma("unroll") for (int _i = 0; _i < 2; ++_i) \
        __builtin_amdgcn_global_load_lds((const unsigned*)((const char*)(gbase) + (voff)[_i]), (PG8_LAS unsigned*)(lds + (bufoff) + ldsw + _i * 8192), 16, 0, 0); } while (0)
#define PG8_LDA(dst, b, h) do { _Pragma("unroll") for (int m = 0; m < 4; ++m) _Pragma("unroll") for (int k = 0; k < 2; ++k) dst[m][k] = *(const PG8_LAS bf16x8*)(lds + PG8_SA(b, h) + aoff + m * 2048 + k * 1024); } while (0)
#define PG8_LDB(dst, b, h) do { _Pragma("unroll") for (int n = 0; n < 2; ++n) _Pragma("unroll") for (int k = 0; k < 2; ++k) dst[n][k] = *(const PG8_LAS bf16x8*)(lds + PG8_SB(b, h) + boff + n * 2048 + k * 1024); } while (0)
#define PG8_MMA(ai, bj, At, Bt) do { __builtin_amdgcn_s_setprio(1); _Pragma("unroll") for (int m = 0; m < 4; ++m) _Pragma("unroll") for (int n = 0; n < 2; ++n) _Pragma("unroll") for (int k = 0; k < 2; ++k) \
        acc[ai][bj][m][n] = __builtin_amdgcn_mfma_f32_16x16x32_bf16(Bt[n][k], At[m][k], acc[ai][bj][m][n], 0, 0, 0); __builtin_amdgcn_s_setprio(0); } while (0)
#define PG8_WAIT_V(n) asm volatile("s_waitcnt vmcnt(" #n ")" ::: "memory")
#define PG8_WAIT_L(n) asm volatile("s_waitcnt lgkmcnt(" #n ")" ::: "memory")
#define PG8_BAR __builtin_amdgcn_s_barrier()
#define PG8_SCHED __builtin_amdgcn_sched_barrier(0)
    Unit cur, nxt; int ui = 0;
    if (!S.next(0, cur)) return;
    f32x4 acc[2][2][4][2];
#pragma unroll
    for (int a = 0; a < 2; ++a)
#pragma unroll
        for (int b = 0; b < 2; ++b)
#pragma unroll
            for (int m = 0; m < 4; ++m)
#pragma unroll
                for (int n = 0; n < 2; ++n) acc[a][b][m][n] = (f32x4){0.f, 0.f, 0.f, 0.f};
    bf16x8 At[4][2], B0[2][2], B1[2][2];
    const char* cA = (const char*)g.A + (size_t)cur.pm * tstep; const char* cB = (const char*)g.Bt + (size_t)cur.pn * tstep;
    S.a_ready(cur);
    if constexpr (SP2) {
        PG8_STAGE(PG8_SB(0, 0), cB, voffB); PG8_STAGE(PG8_SB(0, 1), cB + hstep, voffB); PG8_STAGE(PG8_SA(0, 0), cA, voffA); PG8_STAGE(PG8_SA(0, 1), cA + hstep, voffA);
        if (wr == 1) PG8_BAR;
        PG8_WAIT_V(2); PG8_BAR;
        PG8_STAGE(PG8_SB(1, 0), cB + kstep, voffB); PG8_STAGE(PG8_SA(1, 0), cA + kstep, voffA); PG8_STAGE(PG8_SB(1, 1), cB + hstep + kstep, voffB);
        PG8_WAIT_V(6); PG8_BAR;
    } else {
        PG8_STAGE(PG8_SB(0, 0), cB, voffB); PG8_STAGE(PG8_SA(0, 0), cA, voffA); PG8_STAGE(PG8_SB(0, 1), cB + hstep, voffB); PG8_STAGE(PG8_SA(0, 1), cA + hstep, voffA);
        if (wr == 1) PG8_BAR;
        PG8_WAIT_V(4); PG8_BAR;
        PG8_STAGE(PG8_SB(1, 0), cB + kstep, voffB); PG8_STAGE(PG8_SA(1, 0), cA + kstep, voffA); PG8_STAGE(PG8_SB(1, 1), cB + hstep + kstep, voffB);
        PG8_WAIT_V(6); PG8_BAR;
    }
    for (;;) {
        const bool has_next = S.next(ui + 1, nxt);
        const char* nA = has_next ? (const char*)g.A + (size_t)nxt.pm * tstep : cA; const char* nB = has_next ? (const char*)g.Bt + (size_t)nxt.pn * tstep : cB;
        for (int t = 0; t < nt; t += 2) {
            const bool last = (t == nt - 2);
            const char* a1 = cA + (size_t)(t + 1) * kstep;
            const char* a2 = last ? nA : cA + (size_t)(t + 2) * kstep; const char* b2 = last ? nB : cB + (size_t)(t + 2) * kstep;
            const char* a3 = a2 + kstep; const char* b3 = b2 + kstep;
            if (last && has_next) S.a_ready(nxt);
            if constexpr (SP2) {
            PG8_LDB(B0, 0, 0); PG8_LDB(B1, 0, 1); PG8_SCHED; PG8_LDA(At, 0, 0); PG8_STAGE(PG8_SA(1, 1), a1 + hstep, voffA);
            PG8_WAIT_V(8); PG8_WAIT_L(0); PG8_BAR; PG8_MMA(0, 0, At, B0); PG8_MMA(0, 1, At, B1); PG8_BAR; PG8_SCHED;
            PG8_LDA(At, 0, 1); PG8_STAGE(PG8_SB(0, 0), b2, voffB); PG8_STAGE(PG8_SB(0, 1), b2 + hstep, voffB); PG8_STAGE(PG8_SA(0, 0), a2, voffA);
            PG8_WAIT_V(8); PG8_WAIT_L(0); PG8_BAR; PG8_MMA(1, 0, At, B0); PG8_MMA(1, 1, At, B1); PG8_BAR; PG8_SCHED;
            PG8_LDB(B0, 1, 0); PG8_LDB(B1, 1, 1); PG8_SCHED; PG8_LDA(At, 1, 0); PG8_STAGE(PG8_SA(0, 1), a2 + hstep, voffA);
            PG8_WAIT_V(8); PG8_WAIT_L(0); PG8_BAR; PG8_MMA(0, 0, At, B0); PG8_MMA(0, 1, At, B1); PG8_BAR; PG8_SCHED;
            PG8_LDA(At, 1, 1); PG8_STAGE(PG8_SB(1, 0), b3, voffB); PG8_STAGE(PG8_SB(1, 1), b3 + hstep, voffB); PG8_STAGE(PG8_SA(1, 0), a3, voffA);
            PG8_WAIT_V(8); PG8_WAIT_L(0); PG8_BAR; PG8_MMA(1, 0, At, B0); PG8_MMA(1, 1, At, B1); PG8_BAR; PG8_SCHED;
            } else {
            PG8_LDB(B0, 0, 0); PG8_SCHED; PG8_LDA(At, 0, 0); PG8_STAGE(PG8_SA(1, 1), a1 + hstep, voffA);
            PG8_WAIT_L(8); PG8_BAR; PG8_WAIT_L(0); PG8_MMA(0, 0, At, B0); PG8_BAR; PG8_SCHED;
            PG8_LDB(B1, 0, 1); PG8_STAGE(PG8_SB(0, 0), b2, voffB);
            PG8_BAR; PG8_WAIT_L(0); PG8_MMA(0, 1, At, B1); PG8_BAR;
            PG8_LDA(At, 0, 1); PG8_STAGE(PG8_SA(0, 0), a2, voffA);
            PG8_BAR; PG8_WAIT_L(0); PG8_MMA(1, 0, At, B0); PG8_BAR; PG8_SCHED;
            PG8_STAGE(PG8_SB(0, 1), b2 + hstep, voffB);
            PG8_WAIT_V(6); PG8_BAR; PG8_MMA(1, 1, At, B1); PG8_BAR;
            PG8_LDB(B0, 1, 0); PG8_SCHED; PG8_LDA(At, 1, 0); PG8_STAGE(PG8_SA(0, 1), a2 + hstep, voffA);
            PG8_WAIT_L(8); PG8_BAR; PG8_WAIT_L(0); PG8_MMA(0, 0, At, B0); PG8_BAR; PG8_SCHED;
            PG8_LDB(B1, 1, 1); PG8_STAGE(PG8_SB(1, 0), b3, voffB);
            PG8_BAR; PG8_WAIT_L(0); PG8_MMA(0, 1, At, B1); PG8_BAR;
            PG8_LDA(At, 1, 1); PG8_STAGE(PG8_SA(1, 0), a3, voffA);
            PG8_BAR; PG8_WAIT_L(0); PG8_MMA(1, 0, At, B0); PG8_BAR; PG8_SCHED;
            PG8_STAGE(PG8_SB(1, 1), b3 + hstep, voffB);
            PG8_WAIT_V(6); PG8_BAR; PG8_MMA(1, 1, At, B1); PG8_BAR;
            }
        }
        if constexpr (ALIGN_EPI) { if (wr == 0) PG8_BAR; }
        if constexpr (!Epi::AFTER_DRAIN) { E(acc, cur, wr, wc, fr, fq); S.done(cur); }
        if (!has_next) break;
#pragma unroll
        for (int a = 0; a < 2; ++a)
#pragma unroll
            for (int b = 0; b < 2; ++b)
#pragma unroll
                for (int m = 0; m < 4; ++m)
#pragma unroll
                    for (int n = 0; n < 2; ++n) acc[a][b][m][n] = (f32x4){0.f, 0.f, 0.f, 0.f};
        cur = nxt; cA = nA; cB = nB; ++ui;
        if constexpr (ALIGN_EPI) { if (wr == 1) PG8_BAR; }
    }
    PG8_WAIT_V(0);
    if constexpr (!ALIGN_EPI) { if (wr == 0) PG8_BAR; }
    PG8_BAR;
    if constexpr (Epi::AFTER_DRAIN) { E.fused(acc, cur, wr, wc, fr, fq, lds, wid, lane); S.done(cur); }
#undef PG8_SA
#undef PG8_SB
#undef PG8_STAGE
#undef PG8_LDA
#undef PG8_LDB
#undef PG8_MMA
#undef PG8_WAIT_V
#undef PG8_WAIT_L
#undef PG8_BAR
#undef PG8_SCHED
}
}

namespace att {
using bf16x8 = __attribute__((ext_vector_type(8))) short;
using s16x4  = __attribute__((ext_vector_type(4))) short;
using f32x16 = __attribute__((ext_vector_type(16))) float;
using u32x4  = __attribute__((ext_vector_type(4))) unsigned;
typedef unsigned short bf16_t;
constexpr int   D = 128, NW = 8, QBLK = 32, KVBLK = 64;
constexpr float SCALE = 0.088388347648318440f;
constexpr float THR = 8.f;
constexpr size_t SHM_V = KVBLK * D * 2, SHM_K = KVBLK * D * 2, SHM_ATTN = 2 * SHM_V + 2 * SHM_K + NW * 64 * 4;
#define KSWZ(row, colB) ((row) * 256 + ((colB) ^ (((row) & 7) << 4)))
#define SBAR() __builtin_amdgcn_sched_barrier(0)
__device__ __forceinline__ int crow(int r, int hi) { return (r & 3) + 8 * (r >> 2) + 4 * hi; }
__device__ __forceinline__ unsigned cvtpk(float lo, float hi) { unsigned r; asm volatile("v_cvt_pk_bf16_f32 %0, %1, %2" : "=v"(r) : "v"(lo), "v"(hi)); return r; }
__device__ __forceinline__ bf16_t f2bf(float f) { return (bf16_t)(cvtpk(f, 0.f) & 0xffffu); }
__device__ __forceinline__ float bf2f(bf16_t h) { return __builtin_bit_cast(float, (unsigned)h << 16); }

__device__ __forceinline__ void partialSM(f32x16& p0, f32x16& p1, float& m_reg, float& mn, float& alpha) {
  constexpr float C = SCALE * 1.4426950408889634f;
  float pmax = p0[0]; for (int r = 1; r < 16; ++r) pmax = fmaxf(pmax, p0[r]); for (int r = 0; r < 16; ++r) pmax = fmaxf(pmax, p1[r]);
  { auto rr = __builtin_amdgcn_permlane32_swap(__float_as_uint(pmax), __float_as_uint(pmax), false, false);
    pmax = fmaxf(__uint_as_float(rr[0]), __uint_as_float(rr[1])); }
  if (__builtin_expect(__all(pmax - m_reg <= THR / SCALE), 1)) { mn = m_reg; alpha = 1.f; }
  else { mn = fmaxf(m_reg, pmax); alpha = __builtin_amdgcn_exp2f((m_reg - mn) * C); m_reg = mn; }
  float mnC = -mn * C;
  for (int r = 0; r < 16; ++r) p0[r] = fmaf(p0[r], C, mnC); for (int r = 0; r < 16; ++r) p1[r] = fmaf(p1[r], C, mnC);
  for (int r = 0; r < 16; ++r) p0[r] = __builtin_amdgcn_exp2f(p0[r]);
}
#define PK4(P, BASE, OUT) do { unsigned a0 = cvtpk(P[BASE + 0], P[BASE + 1]), a1 = cvtpk(P[BASE + 2], P[BASE + 3]);   \
    unsigned b0 = cvtpk(P[BASE + 4], P[BASE + 5]), b1 = cvtpk(P[BASE + 6], P[BASE + 7]);                              \
    auto r0 = __builtin_amdgcn_permlane32_swap(a0, b0, false, false); auto r1 = __builtin_amdgcn_permlane32_swap(a1, b1, false, false); \
    u32x4 w = {r0[0], r1[0], r0[1], r1[1]}; OUT = *reinterpret_cast<bf16x8*>(&w); } while (0)
__device__ __forceinline__ void finishSM(f32x16& p0, f32x16& p1, float alpha, float& l_reg, bf16x8& pa0, bf16x8& pa1, bf16x8& pa2, bf16x8& pa3) {
  for (int r = 0; r < 16; ++r) p1[r] = __builtin_amdgcn_exp2f(p1[r]);
  float ps = 0; for (int r = 0; r < 16; ++r) ps += p0[r]; for (int r = 0; r < 16; ++r) ps += p1[r];
  { auto rr = __builtin_amdgcn_permlane32_swap(__float_as_uint(ps), __float_as_uint(ps), false, false);
    ps = __uint_as_float(rr[0]) + __uint_as_float(rr[1]); }
  l_reg = l_reg * alpha + ps;
  PK4(p0, 0, pa0); PK4(p0, 8, pa1); PK4(p1, 0, pa2); PK4(p1, 8, pa3);
}
__device__ __forceinline__ void qkt(f32x16& p0, f32x16& p1, const bf16_t* Ks, const bf16x8* qr, int r32, int hi) {
  p0 = f32x16{}; p1 = f32x16{};
#pragma unroll
  for (int d0 = 0; d0 < 8; ++d0) { int cb = (d0 * 16 + hi * 8) * 2;
    bf16x8 b0 = *reinterpret_cast<const bf16x8*>((const char*)Ks + KSWZ(r32, cb));
    bf16x8 b1 = *reinterpret_cast<const bf16x8*>((const char*)Ks + KSWZ(32 + r32, cb));
    p0 = __builtin_amdgcn_mfma_f32_32x32x16_bf16(b0, qr[d0], p0, 0, 0, 0);
    p1 = __builtin_amdgcn_mfma_f32_32x32x16_bf16(b1, qr[d0], p1, 0, 0, 0); }
}
__device__ __forceinline__ int v_st(int k, int c) { const int kk = (k & ~0xC) | ((k & 4) << 1) | ((k & 8) >> 1); return ((kk >> 3) * 4 + (c >> 5)) * 512 + ((kk & 7) * 32 + (c & 31)) * 2; }
__device__ __forceinline__ int v_rd_base(int lane) { return ((lane & 3) << 3) | (((lane >> 2) & 3) << 6) | (((lane >> 4) & 1) << 5) | (((lane >> 5) & 1) << 8); }
constexpr int v_rd_off(int d0, int ks, int half) { return d0 * 512 + ks * 4096 + half * 2048; }
template <int OFF> __device__ __forceinline__ s16x4 tr_read(int vb) {
  s16x4 r; asm volatile("ds_read_b64_tr_b16 %0, %1 offset:%2" : "=&v"(r) : "v"(vb), "i"(OFF) : "memory"); return r;
}
template <int D0> __device__ __forceinline__ void pv_one(f32x16& od, int vb, bf16x8 pa0, bf16x8 pa1, bf16x8 pa2, bf16x8 pa3) {
  const s16x4 l0 = tr_read<v_rd_off(D0, 0, 0)>(vb), h0 = tr_read<v_rd_off(D0, 0, 1)>(vb), l1 = tr_read<v_rd_off(D0, 1, 0)>(vb), h1 = tr_read<v_rd_off(D0, 1, 1)>(vb);
  const s16x4 l2 = tr_read<v_rd_off(D0, 2, 0)>(vb), h2 = tr_read<v_rd_off(D0, 2, 1)>(vb), l3 = tr_read<v_rd_off(D0, 3, 0)>(vb), h3 = tr_read<v_rd_off(D0, 3, 1)>(vb);
  asm volatile("s_waitcnt lgkmcnt(0)" ::: "memory"); SBAR();
#define PKV(L, H) (bf16x8){L[0], L[1], L[2], L[3], H[0], H[1], H[2], H[3]}
  od = __builtin_amdgcn_mfma_f32_32x32x16_bf16(pa0, PKV(l0, h0), od, 0, 0, 0);
  od = __builtin_amdgcn_mfma_f32_32x32x16_bf16(pa1, PKV(l1, h1), od, 0, 0, 0);
  od = __builtin_amdgcn_mfma_f32_32x32x16_bf16(pa2, PKV(l2, h2), od, 0, 0, 0);
  od = __builtin_amdgcn_mfma_f32_32x32x16_bf16(pa3, PKV(l3, h3), od, 0, 0, 0);
#undef PKV
}
__device__ __forceinline__ void pv_d0(f32x16* o, int vb, bf16x8 pa0, bf16x8 pa1, bf16x8 pa2, bf16x8 pa3) {
  pv_one<0>(o[0], vb, pa0, pa1, pa2, pa3); pv_one<1>(o[1], vb, pa0, pa1, pa2, pa3); pv_one<2>(o[2], vb, pa0, pa1, pa2, pa3); pv_one<3>(o[3], vb, pa0, pa1, pa2, pa3);
}

template <int LDQ, int LDK, int LDO>
__device__ __forceinline__ void attn_dense_body(const bf16_t* Qb, const bf16_t* Kh, const bf16_t* Vh, bf16_t* Ob, int seq, char* lds, int nostore = 0) {
  constexpr int SDEPTH = 2;
  const int tid = threadIdx.x, wid = tid >> 6, lane = tid & 63, r32 = lane & 31, hi = lane >> 5;
  bf16_t* V_lds = (bf16_t*)lds; bf16_t* K_lds = (bf16_t*)(lds + 2 * SHM_V);
  float* ws = (float*)(lds + 2 * SHM_V + 2 * SHM_K) + wid * 64; float* li_l = ws; float* al_l = ws + 32;
  float m_reg = -1e30f, l_reg = 0; f32x16 o[4] = {}; bf16x8 qr[8];
  const bf16_t* Qw = Qb + (long)(wid * QBLK + r32) * LDQ + hi * 8;
#pragma unroll
  for (int d0 = 0; d0 < 8; ++d0) qr[d0] = *reinterpret_cast<const bf16x8*>(Qw + d0 * 16);
  const int sr = tid >> 4, sc = (tid & 15) * 8, vst0 = v_st(sr, sc), vst1 = v_st(32 + sr, sc);
  const int vb0 = (int)(uintptr_t)V_lds + v_rd_base(lane);
  struct { bf16x8 vs0, vs1, ks0, ks1; } sr_[SDEPTH];
#define LD8(p) (*reinterpret_cast<const bf16x8*>(p))
#define SLOAD(i, k0) do { sr_[i].vs0 = LD8(&Vh[(long)((k0) + sr) * LDK + sc]); sr_[i].vs1 = LD8(&Vh[(long)((k0) + 32 + sr) * LDK + sc]); \
    sr_[i].ks0 = LD8(&Kh[(long)((k0) + sr) * LDK + sc]); sr_[i].ks1 = LD8(&Kh[(long)((k0) + 32 + sr) * LDK + sc]); } while (0)
#define SWRITE(b, i) do { *(bf16x8*)((char*)V_lds + (b) * SHM_V + vst0) = sr_[i].vs0;          \
    *(bf16x8*)((char*)V_lds + (b) * SHM_V + vst1) = sr_[i].vs1; int kc = sc * 2;               \
    *(bf16x8*)((char*)K_lds + (b) * SHM_K + KSWZ(sr, kc)) = sr_[i].ks0;                       \
    *(bf16x8*)((char*)K_lds + (b) * SHM_K + KSWZ(32 + sr, kc)) = sr_[i].ks1; } while (0)
#define SWAIT() asm volatile("s_waitcnt vmcnt(4)" ::: "memory")
#define RESC(a) do { if (__any((a) < 1.f)) { if (hi == 0) al_l[r32] = (a); asm volatile("s_waitcnt lgkmcnt(0)" ::: "memory"); \
    for (int d = 0; d < 4; ++d) for (int r = 0; r < 16; ++r) o[d][r] *= al_l[crow(r, hi)]; } } while (0)
  f32x16 pA0, pA1, pB0, pB1; float mnA, mnB, alA, alB; bf16x8 pa0, pa1, pa2, pa3; const int NT = seq / KVBLK;
  constexpr int SE = 0, SO = SDEPTH - 1;
  SLOAD(SE, 0); asm volatile("s_waitcnt vmcnt(0)" ::: "memory"); SWRITE(0, SE); __syncthreads();
  qkt(pA0, pA1, K_lds, qr, r32, hi); partialSM(pA0, pA1, m_reg, mnA, alA);
  SLOAD(SO, KVBLK); if (2 < NT) SLOAD(SE, 2 * KVBLK);
  SWAIT(); SWRITE(1, SO); __syncthreads();
  for (int j = 1; j + 1 < NT; j += 2) {
    SBAR(); qkt(pB0, pB1, (bf16_t*)((char*)K_lds + SHM_K), qr, r32, hi);
    finishSM(pA0, pA1, alA, l_reg, pa0, pa1, pa2, pa3); SBAR();
    SLOAD(SO, (j + SDEPTH) * KVBLK); SBAR();
    pv_d0(o, vb0, pa0, pa1, pa2, pa3); partialSM(pB0, pB1, m_reg, mnB, alB);
    __syncthreads(); SWAIT(); SWRITE(0, SE);
    RESC(alB); __syncthreads();
    SBAR(); qkt(pA0, pA1, K_lds, qr, r32, hi);
    finishSM(pB0, pB1, alB, l_reg, pa0, pa1, pa2, pa3); SBAR();
    if (j + 3 < NT) SLOAD(SE, (j + 1 + SDEPTH) * KVBLK); SBAR();
    pv_d0(o, vb0 + (int)SHM_V, pa0, pa1, pa2, pa3); partialSM(pA0, pA1, m_reg, mnA, alA);
    __syncthreads(); SWAIT(); SWRITE(1, SO);
    RESC(alA); __syncthreads();
  }
  SBAR(); qkt(pB0, pB1, (bf16_t*)((char*)K_lds + SHM_K), qr, r32, hi);
  finishSM(pA0, pA1, alA, l_reg, pa0, pa1, pa2, pa3); SBAR();
  pv_d0(o, vb0, pa0, pa1, pa2, pa3); partialSM(pB0, pB1, m_reg, mnB, alB);
  __syncthreads(); RESC(alB);
  finishSM(pB0, pB1, alB, l_reg, pa0, pa1, pa2, pa3); SBAR();
  pv_d0(o, vb0 + (int)SHM_V, pa0, pa1, pa2, pa3);
  if (hi == 0) li_l[r32] = l_reg; asm volatile("s_waitcnt lgkmcnt(0)" ::: "memory");
  float rli[16];
#pragma unroll
  for (int r = 0; r < 16; ++r) rli[r] = __builtin_amdgcn_rcpf(li_l[crow(r, hi)]);
  bf16_t* Ow = Ob + (long)(wid * QBLK) * LDO;
  if (!nostore)
#pragma unroll
  for (int r = 0; r < 16; ++r) { int orow = crow(r, hi);
#pragma unroll
    for (int d0 = 0; d0 < 4; ++d0) Ow[(long)orow * LDO + d0 * 32 + r32] = f2bf(o[d0][r] * rli[r]); }
  asm volatile("s_waitcnt vmcnt(0)" ::: "memory");
  __syncthreads();
#undef SLOAD
#undef SWRITE
#undef SWAIT
#undef RESC
}
}

namespace mk {
using att::bf16x8; using att::f32x16; using att::u32x4; using att::bf16_t; using att::crow; using att::f2bf; using att::bf2f; using att::cvtpk;
typedef float f32x4 __attribute__((ext_vector_type(4)));
typedef unsigned u32x2 __attribute__((ext_vector_type(2)));
#define LAS __attribute__((address_space(3)))
constexpr int NWAVES = 8, NTHR = 512;
constexpr int DM = 2048, MTOK = 32768, MPROMPT = 16384, SEQP = 4096, SEQS = 16384;
constexpr int DIN = 4640, DINP = 4864, DFF = 5632, DPLE = 256;
constexpr float EPS = 1e-6f;
constexpr size_t MiB = 1u << 20;
constexpr size_t WS_ROPE = 0, WS_BAR = 512 * 1024, WS_BAR_BYTES = 16384, WS_DEC = 1 * MiB;
constexpr size_t WS_WIN = 2 * MiB, WS_WOUT = 21 * MiB, WS_WGU = 29 * MiB, WS_WDN = 73 * MiB, WS_WPG = 95 * MiB, WS_WPP = 103 * MiB, WS_PB = 104 * MiB;
constexpr size_t WS_MIX = 120 * MiB, WS_KA = 248 * MiB, WS_VA = 264 * MiB, WS_QG = 280 * MiB, WS_KG = 312 * MiB, WS_VG = 344 * MiB, WS_LR = 408 * MiB, WS_ST = 412 * MiB;
constexpr size_t WS_M1 = 248 * MiB, WS_XN = 376 * MiB, WS_HFF = 120 * MiB, WS_M3 = 120 * MiB, WS_END = 504 * MiB;
constexpr size_t DO_H = 0, DO_QF = 0, DO_QB = 32 * MiB, DO_KF = 64 * MiB, DO_KB = 96 * MiB, DO_SUM = 128 * MiB;
constexpr int LDS_BYTES = 147456;

struct Args { const float* in[23]; float* out; unsigned char* ws; int ph_lo, ph_hi, use_cg, pad; };
enum { I_XP = 0, I_XS, I_PP, I_PS, I_GPRE, I_WIN, I_GQ, I_GK, I_WGF, I_BGF, I_WGB, I_BGB, I_GGLA, I_WOUT, I_GPOSTMIX, I_GPREFFN, I_WGU, I_WDN, I_GPOSTFFN, I_GPLEPRE, I_WPG, I_WPP, I_GPLEPOST };

__device__ __forceinline__ float wave_sum(float v) {
#pragma unroll
    for (int o = 1; o < 64; o <<= 1) v += __shfl_xor(v, o);
    return v;
}
__device__ __forceinline__ unsigned pk2(float lo, float hi) { return cvtpk(lo, hi); }
__device__ __forceinline__ const float* xrow_in(const Args& a, int m) { return m < MPROMPT ? a.in[I_XP] + (size_t)m * DM : a.in[I_XS] + (size_t)(m - MPROMPT) * DM; }

#define XB_TMO      128
#define XB_XCNT(j)  (256  + 64 * (j))
#define XB_XSUB(j)  (1280 + 64 * (j))
#define XB_XGEN(j)  (2304 + 64 * (j))
#define XB_TOP      3328
#define XB_TOPGEN   3392
#define XCD_BAR_WORDS 3456
#define XB_SPIN_CAP (1u << 18)

__device__ __forceinline__ unsigned xb_ld(unsigned* p)              { return __hip_atomic_load(p, __ATOMIC_RELAXED, __HIP_MEMORY_SCOPE_AGENT); }
__device__ __forceinline__ unsigned xb_add(unsigned* p, unsigned v) { return __hip_atomic_fetch_add(p, v, __ATOMIC_RELAXED, __HIP_MEMORY_SCOPE_AGENT); }
__device__ __forceinline__ unsigned xb_xcc_id() { return (unsigned)__builtin_amdgcn_s_getreg((3 << 11) | 20) & 0xFu; }
#define XB_SPIN(cond, bar) do { unsigned _sp = 0; while (cond) { __builtin_amdgcn_s_sleep(1); \
    if ((++_sp & 255u) == 0u) { if (xb_ld(&(bar)[XB_TMO])) break; if (_sp > XB_SPIN_CAP) { atomicAdd(&(bar)[XB_TMO], 1u); break; } } } } while (0)

struct XcdBarrier {
    unsigned* bar; unsigned x;
    volatile LAS unsigned* st;
};

__device__ __forceinline__ XcdBarrier xcd_barrier_post(unsigned* bar, volatile LAS unsigned* st) {
    XcdBarrier b; b.bar = bar; b.x = xb_xcc_id(); b.st = st;
    if (threadIdx.x == 0) (void)xb_add(&bar[XB_XCNT(b.x)], 1u);
    return b;
}
__device__ __forceinline__ void xcd_barrier_complete(unsigned* bar, unsigned x, unsigned& nloc, unsigned& nx) {
    const unsigned G = gridDim.x * gridDim.y * gridDim.z;
    unsigned sum, cnt, mine, sp = 0u;
    for (;;) {
        sum = 0u; cnt = 0u; mine = 0u;
#pragma unroll
        for (unsigned j = 0; j < 16; ++j) { const unsigned c = xb_ld(&bar[XB_XCNT(j)]); sum += c; cnt += (c > 0u) ? 1u : 0u; mine = (j == x) ? c : mine; }
        if (sum == G) break;
        __builtin_amdgcn_s_sleep(1);
        if ((++sp & 255u) == 0u) { if (xb_ld(&bar[XB_TMO])) break; if (sp > XB_SPIN_CAP) { atomicAdd(&bar[XB_TMO], 1u); break; } }
    }
    nloc = mine > 0u ? mine : 1u; nx = cnt > 0u ? cnt : 1u;
}

__device__ __forceinline__ void xcd_barrier(const XcdBarrier& b) {
    asm volatile("s_waitcnt vmcnt(0)" ::: "memory");
    __syncthreads();
    if (threadIdx.x == 0) {
        unsigned* bar = b.bar;
        __builtin_amdgcn_s_waitcnt(0);
        unsigned nloc = b.st[0], nx = b.st[1];
        if (nloc == 0u) { xcd_barrier_complete(bar, b.x, nloc, nx); b.st[0] = nloc; b.st[1] = nx; }
        const unsigned old = xb_add(&bar[XB_XSUB(b.x)], 1u);
        const unsigned gen = old / nloc;
        if (old + 1u == (gen + 1u) * nloc) {
            __builtin_amdgcn_fence(__ATOMIC_RELEASE, "agent");
            asm volatile("s_waitcnt vmcnt(0)" ::: "memory");
            const unsigned og = xb_add(&bar[XB_TOP], 1u);
            const unsigned tg = og / nx;
            if (og + 1u == (tg + 1u) * nx) xb_add(&bar[XB_TOPGEN], 1u);
            else XB_SPIN(xb_ld(&bar[XB_TOPGEN]) == tg, bar);
            __builtin_amdgcn_fence(__ATOMIC_ACQUIRE, "agent");
            xb_add(&bar[XB_XGEN(b.x)], 1u);
            asm volatile("s_waitcnt vmcnt(0)" ::: "memory");
        } else {
            XB_SPIN(xb_ld(&bar[XB_XGEN(b.x)]) == gen, bar);
            __builtin_amdgcn_fence(__ATOMIC_ACQUIRE, "agent");
            asm volatile("s_waitcnt vmcnt(0)" ::: "memory");
        }
    }
    __syncthreads();
}

template <int MODE>
__device__ __forceinline__ void p0_transpose_item(const float* W, int K, int N, bf16_t* WT, LAS float* scr, int item, int lane) {
    const int nblk = N / 32, kb = item / nblk, nb = item % nblk, k0 = 64 * kb, n0 = 32 * nb;
    int row0 = n0;
    if (MODE == 1) { if (n0 < DFF) row0 = (n0 >> 7) * 256 + (n0 & 127); else { const int n1 = n0 - DFF; row0 = (n1 >> 7) * 256 + 128 + (n1 & 127); } }
#pragma unroll 8
    for (int i = 0; i < 32; ++i) { const int kk = 2 * i + (lane >> 5); scr[kk * 33 + (lane & 31)] = W[(size_t)(k0 + kk) * N + n0 + (lane & 31)]; }
    asm volatile("s_waitcnt lgkmcnt(0)" ::: "memory");
    const int c = lane & 7;
#pragma unroll
    for (int j = 0; j < 4; ++j) { const int n = (lane >> 3) + 8 * j; const LAS float* s = scr + (8 * c) * 33 + n;
        u32x4 o; o.x = pk2(s[0 * 33], s[1 * 33]); o.y = pk2(s[2 * 33], s[3 * 33]); o.z = pk2(s[4 * 33], s[5 * 33]); o.w = pk2(s[6 * 33], s[7 * 33]);
        *(u32x4*)(WT + (size_t)(row0 + n) * K + k0 + 8 * c) = o; }
    asm volatile("s_waitcnt lgkmcnt(0)" ::: "memory");
}
__device__ __forceinline__ void p0_prologue(const Args& a, unsigned char* lds, int G) {
    unsigned char* ws = a.ws;
    int tid_o = threadIdx.x; asm volatile("" : "+v"(tid_o)); const int tid = tid_o, lane = tid & 63, wave = tid >> 6;
    LAS float* scr = (LAS float*)((LAS unsigned char*)lds + wave * 16384);
    const int gw = blockIdx.x * NWAVES + wave, NGW = G * NWAVES;
    constexpr int I_IN = (DM / 64) * (DIN / 32), I_OUT = (DM / 64) * (DM / 32), I_GU = (DM / 64) * (2 * DFF / 32), I_DN = (DFF / 64) * (DM / 32), I_PG = I_OUT, I_PPJ = (DPLE / 64) * (DM / 32);
    constexpr int NITEMS = I_IN + I_OUT + I_GU + I_DN + I_PG + I_PPJ;
    for (int it = gw; it < NITEMS; it += NGW) {
        int r = it;
        if (r < I_IN) { p0_transpose_item<0>(a.in[I_WIN], DM, DIN, (bf16_t*)(ws + WS_WIN), scr, r, lane); continue; } r -= I_IN;
        if (r < I_OUT) { p0_transpose_item<0>(a.in[I_WOUT], DM, DM, (bf16_t*)(ws + WS_WOUT), scr, r, lane); continue; } r -= I_OUT;
        if (r < I_GU) { p0_transpose_item<1>(a.in[I_WGU], DM, 2 * DFF, (bf16_t*)(ws + WS_WGU), scr, r, lane); continue; } r -= I_GU;
        if (r < I_DN) { p0_transpose_item<0>(a.in[I_WDN], DFF, DM, (bf16_t*)(ws + WS_WDN), scr, r, lane); continue; } r -= I_DN;
        if (r < I_PG) { p0_transpose_item<0>(a.in[I_WPG], DM, DM, (bf16_t*)(ws + WS_WPG), scr, r, lane); continue; } r -= I_PG;
        p0_transpose_item<0>(a.in[I_WPP], DPLE, DM, (bf16_t*)(ws + WS_WPP), scr, r, lane);
    }
    { bf16_t* wt = (bf16_t*)(ws + WS_WIN) + (size_t)DIN * DM; const size_t n16 = (size_t)(DINP - DIN) * DM / 8;
      for (size_t i = (size_t)blockIdx.x * NTHR + tid; i < n16; i += (size_t)G * NTHR) ((u32x4*)wt)[i] = (u32x4){0u, 0u, 0u, 0u}; }
    { bf16_t* H = (bf16_t*)((unsigned char*)a.out + DO_H); const float* g = a.in[I_GPRE];
      for (int m = gw; m < MTOK; m += NGW) {
        const f32x4* xr = (const f32x4*)xrow_in(a, m) + lane; f32x4 v[8]; float s = 0.f;
#pragma unroll
        for (int j = 0; j < 8; ++j) { v[j] = xr[64 * j]; s += (v[j].x * v[j].x + v[j].y * v[j].y) + (v[j].z * v[j].z + v[j].w * v[j].w); }
        const float rstd = __builtin_amdgcn_rsqf(wave_sum(s) * (1.f / DM) + EPS);
        u32x2* o8 = (u32x2*)(H + (size_t)m * DM) + lane;
#pragma unroll
        for (int j = 0; j < 8; ++j) { const f32x4 gg = ((const f32x4*)g)[lane + 64 * j]; u32x2 w; w.x = pk2(v[j].x * rstd * gg.x, v[j].y * rstd * gg.y); w.y = pk2(v[j].z * rstd * gg.z, v[j].w * rstd * gg.w); o8[64 * j] = w; }
      } }
    { bf16_t* PB = (bf16_t*)(ws + WS_PB); const size_t nhalf = (size_t)MPROMPT * DPLE / 8;
      for (size_t i = (size_t)blockIdx.x * NTHR + tid; i < 2 * nhalf; i += (size_t)G * NTHR) {
        const float* src = (i < nhalf) ? a.in[I_PP] + i * 8 : a.in[I_PS] + (i - nhalf) * 8;
        const f32x4 x0 = *(const f32x4*)src, x1 = *(const f32x4*)(src + 4);
        u32x4 w; w.x = pk2(x0.x, x0.y); w.y = pk2(x0.z, x0.w); w.z = pk2(x1.x, x1.y); w.w = pk2(x1.z, x1.w); ((u32x4*)PB)[i] = w; } }
    { float* ct = (float*)(ws + WS_ROPE); float* st = ct + 256 * 32;
      for (int i = blockIdx.x * NTHR + tid; i < 256 * 32; i += G * NTHR) {
        const int pos = i >> 5, fi = i & 31;
        const float freq = __builtin_amdgcn_exp2f(-(float)(2 * fi) * (13.287712379549449f / 64.0f));
        const float ang = (float)pos * freq;
        const double rev = (double)ang * 0.15915494309189535; const float fr = (float)(rev - __builtin_floor(rev));
        ct[i] = __builtin_amdgcn_cosf(fr); st[i] = __builtin_amdgcn_sinf(fr); } }
}

__device__ __forceinline__ void qk_norm_rope(const Args& a, int G, int nostore = 0) {
    unsigned char* ws = a.ws;
    int tid_o = threadIdx.x; asm volatile("" : "+v"(tid_o)); const int tid = tid_o, lane = tid & 63, wave = tid >> 6, sub = lane >> 4, l16 = lane & 15;
    const int gw = blockIdx.x * NWAVES + wave, NGW = G * NWAVES;
    bf16_t* MIX = (bf16_t*)(ws + WS_MIX); bf16_t* KA = (bf16_t*)(ws + WS_KA);
    const float* ct = (const float*)(ws + WS_ROPE); const float* st = ct + 256 * 32;
    const int NIT = MTOK * 10 / 4;
    for (int it = gw; it < NIT; it += NGW) {
        const int idx = it * 4 + sub, tok = idx / 10, hh = idx - tok * 10;
        bf16_t* p = (hh < 8) ? MIX + (size_t)tok * 2048 + hh * 128 + l16 * 8 : KA + (size_t)tok * 256 + (hh - 8) * 128 + l16 * 8;
        const float* g = ((hh < 8) ? a.in[I_GQ] : a.in[I_GK]) + l16 * 8;
        const u32x4 w = *(const u32x4*)p;
        float x[8] = {pg8::bf_lo(w.x), pg8::bf_hi(w.x), pg8::bf_lo(w.y), pg8::bf_hi(w.y), pg8::bf_lo(w.z), pg8::bf_hi(w.z), pg8::bf_lo(w.w), pg8::bf_hi(w.w)};
        float s = 0.f;
#pragma unroll
        for (int e = 0; e < 8; ++e) s += x[e] * x[e];
        s += __shfl_xor(s, 1); s += __shfl_xor(s, 2); s += __shfl_xor(s, 4); s += __shfl_xor(s, 8);
        const float rstd = __builtin_amdgcn_rsqf(s * (1.f / 128.f) + EPS);
        const f32x4 g0 = *(const f32x4*)g, g1 = *(const f32x4*)(g + 4);
        const float gg[8] = {g0.x, g0.y, g0.z, g0.w, g1.x, g1.y, g1.z, g1.w};
#pragma unroll
        for (int e = 0; e < 8; ++e) x[e] *= rstd * gg[e];
        const int spos = tok < MPROMPT ? (tok & (SEQP - 1)) : tok - MPROMPT;
        const int e0 = l16 * 8, part = e0 >> 6, i0 = e0 & 63, pos = part ? (spos & 63) : (spos >> 6), fi = i0 & 31;
        float y[8];
#pragma unroll
        for (int e = 0; e < 8; ++e) y[e] = __shfl_xor(x[e], 4);
        const f32x4 c0 = *(const f32x4*)(ct + pos * 32 + fi), c1 = *(const f32x4*)(ct + pos * 32 + fi + 4), s0 = *(const f32x4*)(st + pos * 32 + fi), s1 = *(const f32x4*)(st + pos * 32 + fi + 4);
        const float cc[8] = {c0.x, c0.y, c0.z, c0.w, c1.x, c1.y, c1.z, c1.w}, ss[8] = {s0.x, s0.y, s0.z, s0.w, s1.x, s1.y, s1.z, s1.w};
        const float sgn = (i0 < 32) ? -1.f : 1.f;
        float r[8];
#pragma unroll
        for (int e = 0; e < 8; ++e) r[e] = x[e] * cc[e] + sgn * y[e] * ss[e];
        u32x4 o; o.x = pk2(r[0], r[1]); o.y = pk2(r[2], r[3]); o.z = pk2(r[4], r[5]); o.w = pk2(r[6], r[7]);
        if (!nostore) *(u32x4*)p = o;
    }
}

__device__ __forceinline__ float logsig16(float z) { return (fminf(z, 0.f) - __logf(1.0f + __expf(-fabsf(z)))) * (1.0f / 16.0f); }

__device__ __forceinline__ void g1_unit(const Args& a, char* lds, int scg, int h) {
    unsigned char* ws = a.ws; unsigned char* dob = (unsigned char*)a.out;
    int tid_o = threadIdx.x; asm volatile("" : "+v"(tid_o)); const int tid = tid_o, wid = tid >> 6, lane = tid & 63, r32 = lane & 31, hi = lane >> 5;
    const int d = tid & 127, qtr = tid >> 7;
    constexpr int KT_PITCH = 528;
    char* kT = lds; char* Vs = lds + 67584; float* LRs = (float*)(lds + 100352); float* qsum = (float*)(lds + 116736); float* dtot = (float*)(lds + 118784);
    const long tok0 = (long)scg * 256;
    const bf16_t* QG = (const bf16_t*)(ws + WS_QG); const bf16_t* KG = (const bf16_t*)(ws + WS_KG); const bf16_t* VG = (const bf16_t*)(ws + WS_VG);
    const float* LR = (const float*)(ws + WS_LR);
    const int sr = tid >> 4, sc = (tid & 15) * 8, vst0 = att::v_st(sr, sc), vst1 = att::v_st(32 + sr, sc);
    for (int dir = 0; dir < 2; ++dir) {
        bf16_t* QX = (bf16_t*)(dob + (dir ? DO_QB : DO_QF)); bf16_t* KX = (bf16_t*)(dob + (dir ? DO_KB : DO_KF));
        const float* wup = a.in[dir ? I_WGB : I_WGF]; const float* bup = a.in[dir ? I_BGB : I_BGF];
        __syncthreads();
        { const int t = tid >> 1, hf = tid & 1; const float* src = LR + (tok0 + t) * 32 + dir * 16 + hf * 8;
          *(f32x4*)(LRs + t * 16 + hf * 8) = *(const f32x4*)src; *(f32x4*)(LRs + t * 16 + hf * 8 + 4) = *(const f32x4*)(src + 4); }
        float w[16];
#pragma unroll
        for (int r = 0; r < 16; ++r) w[r] = wup[r * 512 + h * 128 + d];
        const float bias = bup[h * 128 + d];
        __syncthreads();
        float run = 0.f;
#pragma unroll 2
        for (int i = 0; i < 64; ++i) { const float* lr = LRs + (qtr * 64 + i) * 16; float z = bias;
#pragma unroll
            for (int r = 0; r < 16; ++r) z = fmaf(lr[r], w[r], z);
            run += logsig16(z); }
        qsum[qtr * 128 + d] = run;
        __syncthreads();
        const float q0 = qsum[d], q1 = qsum[128 + d], q2 = qsum[256 + d], q3 = qsum[384 + d];
        const float tot = (q0 + q1) + (q2 + q3);
        if (qtr == 0) dtot[d] = __expf(tot);
        float before = (qtr > 0 ? q0 : 0.f) + (qtr > 1 ? q1 : 0.f) + (qtr > 2 ? q2 : 0.f);
        float acc = dir ? (tot - before) : before;
        for (int i8 = 0; i8 < 64; i8 += 8) {
            unsigned pk[4];
#pragma unroll
            for (int ii = 0; ii < 8; ++ii) {
                const int i = i8 + ii; const long tok = tok0 + qtr * 64 + i;
                const float* lr = LRs + (qtr * 64 + i) * 16; float z = bias;
#pragma unroll
                for (int r = 0; r < 16; ++r) z = fmaf(lr[r], w[r], z);
                const float l = logsig16(z); float B;
                if (dir == 0) { acc += l; B = acc; } else { B = acc; acc -= l; }
                B = fmaxf(B, -80.f);
                const float e = __expf(B), ei = __expf(-B);
                const size_t off = (size_t)tok * 512 + h * 128 + d;
                const float qv = bf2f(QG[off]) * (0.088388347648318440f * e), kv = bf2f(KG[off]) * ei;
                QX[off] = f2bf(qv); const bf16_t kb = f2bf(kv); KX[off] = kb;
                if (ii & 1) pk[ii >> 1] |= (unsigned)kb << 16; else pk[ii >> 1] = kb;
            }
            *(u32x4*)(kT + d * KT_PITCH + (qtr * 64 + i8) * 2) = (u32x4){pk[0], pk[1], pk[2], pk[3]};
        }
        const int db = wid & 3, vh = wid >> 2;
        f32x16 c[4] = {};
        const int vb = (int)(uintptr_t)Vs + vh * 16384 + att::v_rd_base(lane);
        for (int tile = 0; tile < 4; ++tile) {
            const bf16_t* vp = VG + (size_t)(tok0 + tile * 64 + sr) * 1024 + h * 256 + sc;
            const bf16x8 v0 = *(const bf16x8*)vp, v1 = *(const bf16x8*)(vp + 32 * 1024), v2 = *(const bf16x8*)(vp + 128), v3 = *(const bf16x8*)(vp + 32 * 1024 + 128);
            __syncthreads();
            *(bf16x8*)(Vs + vst0) = v0; *(bf16x8*)(Vs + vst1) = v1; *(bf16x8*)(Vs + 16384 + vst0) = v2; *(bf16x8*)(Vs + 16384 + vst1) = v3;
            __syncthreads();
            const char* kr = kT + (db * 32 + r32) * KT_PITCH + (tile * 64 + hi * 8) * 2;
            const bf16x8 a0 = *(const bf16x8*)(kr), a1 = *(const bf16x8*)(kr + 32), a2 = *(const bf16x8*)(kr + 64), a3 = *(const bf16x8*)(kr + 96);
            att::pv_d0(c, vb, a0, a1, a2, a3);
        }
        const size_t sidx = ((size_t)(scg * 4 + h) * 2 + dir);
        float* SUM = (float*)(dob + DO_SUM) + sidx * 32768;
#pragma unroll
        for (int r = 0; r < 16; ++r) { const int row = db * 32 + crow(r, hi); const float dt = dtot[row];
#pragma unroll
            for (int d0 = 0; d0 < 4; ++d0) SUM[row * 256 + vh * 128 + d0 * 32 + r32] = c[d0][r] * dt; }
        if (qtr == 0) ((float*)(ws + WS_DEC))[sidx * 128 + d] = dtot[d];
    }
    __syncthreads();
}

__device__ __forceinline__ void g2_scan(const Args& a, int G) {
    unsigned char* ws = a.ws; unsigned char* dob = (unsigned char*)a.out;
    const f32x4* SUM4 = (const f32x4*)(dob + DO_SUM); const float* DEC = (const float*)(ws + WS_DEC); u32x2* ST2 = (u32x2*)(ws + WS_ST);
    for (int item = blockIdx.x * NTHR + threadIdx.x; item < 40 * 8192; item += G * NTHR) {
        const int c = item >> 13, e4 = item & 8191, dir = c & 1, h = (c >> 1) & 3, seq = c >> 3;
        const int nsc = seq < 4 ? 16 : 64, scbase = seq < 4 ? seq * 16 : 64, dd = e4 >> 6;
        f32x4 S = {0.f, 0.f, 0.f, 0.f};
        for (int i = 0; i < nsc; ++i) {
            const int sc = dir ? scbase + nsc - 1 - i : scbase + i;
            const size_t idx = (size_t)(sc * 4 + h) * 2 + dir;
            u32x2 w; w.x = pk2(S.x, S.y); w.y = pk2(S.z, S.w); ST2[idx * 8192 + e4] = w;
            const float dec = DEC[idx * 128 + dd]; const f32x4 kv = SUM4[idx * 8192 + e4];
            S = S * dec + kv;
        }
    }
}

__device__ __forceinline__ void g3_unit(const Args& a, char* lds, int scg, int h, int rh, int nostore = 0) {
    unsigned char* ws = a.ws; unsigned char* dob = (unsigned char*)a.out;
    int tid_o = threadIdx.x; asm volatile("" : "+v"(tid_o)); const int tid = tid_o, wid = tid >> 6, lane = tid & 63, r32 = lane & 31, hi = lane >> 5;
    const int rg = wid & 3, vh = wid >> 2;
    bf16_t* KFs = (bf16_t*)lds; bf16_t* KBs = (bf16_t*)(lds + 16384); char* Vs = lds + 32768; float* xs = (float*)(lds + 65536);
    const bf16_t* QF = (const bf16_t*)(dob + DO_QF); const bf16_t* QB = (const bf16_t*)(dob + DO_QB); const bf16_t* KF = (const bf16_t*)(dob + DO_KF); const bf16_t* KB = (const bf16_t*)(dob + DO_KB);
    const bf16_t* VG = (const bf16_t*)(ws + WS_VG); const bf16_t* ST = (const bf16_t*)(ws + WS_ST); bf16_t* MIX = (bf16_t*)(ws + WS_MIX);
    const long tok0 = (long)scg * 256; const int qlo = rh * 128 + rg * 32;
    const size_t qo = (size_t)(tok0 + qlo + r32) * 512 + h * 128 + hi * 8;
#define G3_LDQ(QX, SRC) do { _Pragma("unroll") for (int d0 = 0; d0 < 8; ++d0) QX[d0] = *(const bf16x8*)((SRC) + qo + d0 * 16); } while (0)
    f32x16 o[4] = {};
    const int sr = tid >> 4, sc = (tid & 15) * 8, vst0 = att::v_st(sr, sc), vst1 = att::v_st(32 + sr, sc);
    const int vb = (int)(uintptr_t)Vs + vh * 16384 + att::v_rd_base(lane);
#define G3_INTER(DIR, DT, QX) do { const bf16_t* Sg = ST + (((size_t)(scg * 4 + h) * 2 + (DIR)) * 128 + (DT) * 64 + sr) * 256 + sc; \
        const bf16x8 s0 = *(const bf16x8*)Sg, s1 = *(const bf16x8*)(Sg + 32 * 256), s2 = *(const bf16x8*)(Sg + 128), s3 = *(const bf16x8*)(Sg + 32 * 256 + 128); \
        __syncthreads(); \
        *(bf16x8*)(Vs + vst0) = s0; *(bf16x8*)(Vs + vst1) = s1; *(bf16x8*)(Vs + 16384 + vst0) = s2; *(bf16x8*)(Vs + 16384 + vst1) = s3; \
        __syncthreads(); \
        att::pv_d0(o, vb, QX[4 * (DT) + 0], QX[4 * (DT) + 1], QX[4 * (DT) + 2], QX[4 * (DT) + 3]); } while (0)
    { bf16x8 qx[8]; G3_LDQ(qx, QF); G3_INTER(0, 0, qx); G3_INTER(0, 1, qx); }
    { bf16x8 qx[8]; G3_LDQ(qx, QB); G3_INTER(1, 0, qx); G3_INTER(1, 1, qx); }
#undef G3_INTER
    const int iq = qlo + r32;
    for (int J = 0; J < 4; ++J) {
        const long k0 = tok0 + 64 * J;
        const size_t ko = (size_t)(k0 + sr) * 512 + h * 128 + sc;
        const bf16x8 f0 = *(const bf16x8*)(KF + ko), f1 = *(const bf16x8*)(KF + ko + 32 * 512), b0 = *(const bf16x8*)(KB + ko), b1 = *(const bf16x8*)(KB + ko + 32 * 512);
        const bf16_t* vp = VG + (size_t)(k0 + sr) * 1024 + h * 256 + sc;
        const bf16x8 v0 = *(const bf16x8*)vp, v1 = *(const bf16x8*)(vp + 32 * 1024), v2 = *(const bf16x8*)(vp + 128), v3 = *(const bf16x8*)(vp + 32 * 1024 + 128);
        __syncthreads();
        { const int kc = sc * 2;
          *(bf16x8*)((char*)KFs + KSWZ(sr, kc)) = f0; *(bf16x8*)((char*)KFs + KSWZ(32 + sr, kc)) = f1; *(bf16x8*)((char*)KBs + KSWZ(sr, kc)) = b0; *(bf16x8*)((char*)KBs + KSWZ(32 + sr, kc)) = b1; }
        *(bf16x8*)(Vs + vst0) = v0; *(bf16x8*)(Vs + vst1) = v1; *(bf16x8*)(Vs + 16384 + vst0) = v2; *(bf16x8*)(Vs + 16384 + vst1) = v3;
        __syncthreads();
        const int klo = 64 * J;
        const bool needF = (klo <= qlo + 31), needB = (klo + 63 > qlo);
        f32x16 pF0, pF1, pB0, pB1;
        if (needF) { bf16x8 qx[8]; G3_LDQ(qx, QF); att::qkt(pF0, pF1, KFs, qx, r32, hi); } else { pF0 = f32x16{}; pF1 = f32x16{}; }
        if (needB) { bf16x8 qx[8]; G3_LDQ(qx, QB); att::qkt(pB0, pB1, KBs, qx, r32, hi); } else { pB0 = f32x16{}; pB1 = f32x16{}; }
#pragma unroll
        for (int r = 0; r < 16; ++r) { const int j0 = klo + crow(r, hi); pF0[r] = (j0 <= iq) ? pF0[r] : pB0[r]; pF1[r] = (j0 + 32 <= iq) ? pF1[r] : pB1[r]; }
        bf16x8 pa0, pa1, pa2, pa3;
        PK4(pF0, 0, pa0); PK4(pF0, 8, pa1); PK4(pF1, 0, pa2); PK4(pF1, 8, pa3);
        att::pv_d0(o, vb, pa0, pa1, pa2, pa3);
    }
    float ss[16];
#pragma unroll
    for (int r = 0; r < 16; ++r) { float s = 0.f;
#pragma unroll
        for (int d0 = 0; d0 < 4; ++d0) s += o[d0][r] * o[d0][r];
        s += __shfl_xor(s, 1); s += __shfl_xor(s, 2); s += __shfl_xor(s, 4); s += __shfl_xor(s, 8); s += __shfl_xor(s, 16); ss[r] = s; }
    if (r32 == 0) {
#pragma unroll
        for (int r = 0; r < 16; ++r) xs[vh * 128 + rg * 32 + crow(r, hi)] = ss[r]; }
    __syncthreads();
    const float* gn = a.in[I_GGLA];
    float gcol[4];
#pragma unroll
    for (int d0 = 0; d0 < 4; ++d0) gcol[d0] = gn[vh * 128 + d0 * 32 + r32];
#pragma unroll
    for (int r = 0; r < 16; ++r) { const int rr = rg * 32 + crow(r, hi);
        const float rstd = __builtin_amdgcn_rsqf((xs[rr] + xs[128 + rr]) * (1.f / 256.f) + EPS);
        bf16_t* mp = MIX + (size_t)(tok0 + rh * 128 + rr) * 2048 + 1024 + h * 256 + vh * 128 + r32;
#pragma unroll
        for (int d0 = 0; d0 < 4; ++d0) { const float gt = bf2f(mp[d0 * 32]); const float y = o[d0][r] * rstd * gcol[d0] * gt * __builtin_amdgcn_rcpf(1.0f + __expf(-gt)); if (!nostore) mp[d0 * 32] = f2bf(y); } }
    __syncthreads();
}

template <bool FROM_IN, bool HAS_XN>
__device__ __forceinline__ void row_pass(const Args& a, int G, const bf16_t* Mb, const float* g1, const float* g2, bf16_t* XN) {
    int tid_o = threadIdx.x; asm volatile("" : "+v"(tid_o)); const int tid = tid_o, lane = tid & 63, wave = tid >> 6;
    const int gw = blockIdx.x * NWAVES + wave, NGW = G * NWAVES;
    for (int m = gw; m < MTOK; m += NGW) {
        const float* xi = FROM_IN ? xrow_in(a, m) : a.out + (size_t)m * DM; float* xo = a.out + (size_t)m * DM;
        float mv[4][8], xv[4][8]; float s = 0.f;
#pragma unroll
        for (int j = 0; j < 4; ++j) { const int c = (lane + 64 * j) * 8; const u32x4 w = *(const u32x4*)(Mb + (size_t)m * DM + c);
            mv[j][0] = pg8::bf_lo(w.x); mv[j][1] = pg8::bf_hi(w.x); mv[j][2] = pg8::bf_lo(w.y); mv[j][3] = pg8::bf_hi(w.y); mv[j][4] = pg8::bf_lo(w.z); mv[j][5] = pg8::bf_hi(w.z); mv[j][6] = pg8::bf_lo(w.w); mv[j][7] = pg8::bf_hi(w.w);
            const f32x4 x0 = *(const f32x4*)(xi + c), x1 = *(const f32x4*)(xi + c + 4);
            xv[j][0] = x0.x; xv[j][1] = x0.y; xv[j][2] = x0.z; xv[j][3] = x0.w; xv[j][4] = x1.x; xv[j][5] = x1.y; xv[j][6] = x1.z; xv[j][7] = x1.w;
#pragma unroll
            for (int e = 0; e < 8; ++e) s += mv[j][e] * mv[j][e]; }
        const float rstd = __builtin_amdgcn_rsqf(wave_sum(s) * (1.f / DM) + EPS);
        float s2 = 0.f;
#pragma unroll
        for (int j = 0; j < 4; ++j) { const int c = (lane + 64 * j) * 8; const f32x4 ga = *(const f32x4*)(g1 + c), gb = *(const f32x4*)(g1 + c + 4);
            const float gg[8] = {ga.x, ga.y, ga.z, ga.w, gb.x, gb.y, gb.z, gb.w};
#pragma unroll
            for (int e = 0; e < 8; ++e) { xv[j][e] += mv[j][e] * rstd * gg[e]; s2 += xv[j][e] * xv[j][e]; }
            *(f32x4*)(xo + c) = (f32x4){xv[j][0], xv[j][1], xv[j][2], xv[j][3]}; *(f32x4*)(xo + c + 4) = (f32x4){xv[j][4], xv[j][5], xv[j][6], xv[j][7]}; }
        if (HAS_XN) {
            const float rstd2 = __builtin_amdgcn_rsqf(wave_sum(s2) * (1.f / DM) + EPS);
#pragma unroll
            for (int j = 0; j < 4; ++j) { const int c = (lane + 64 * j) * 8; const f32x4 ga = *(const f32x4*)(g2 + c), gb = *(const f32x4*)(g2 + c + 4);
                u32x4 w; w.x = pk2(xv[j][0] * rstd2 * ga.x, xv[j][1] * rstd2 * ga.y); w.y = pk2(xv[j][2] * rstd2 * ga.z, xv[j][3] * rstd2 * ga.w);
                w.z = pk2(xv[j][4] * rstd2 * gb.x, xv[j][5] * rstd2 * gb.y); w.w = pk2(xv[j][6] * rstd2 * gb.z, xv[j][7] * rstd2 * gb.w);
                *(u32x4*)(XN + (size_t)m * DM + c) = w; }
        }
    }
}

__device__ __forceinline__ void att_item(const Args& a, char* lds, int i, int nostore = 0) {
    unsigned char* ws = a.ws;
    const int k = i >> 8, c = i & 255, xcd = c & 7, j = c >> 3;
    bf16_t* MIX = (bf16_t*)(ws + WS_MIX); const bf16_t* KA = (const bf16_t*)(ws + WS_KA); const bf16_t* VA = (const bf16_t*)(ws + WS_VA);
    int kvh, qh, qb, seq; size_t t0;
    if (k < 2) { kvh = xcd >> 2; const int ii = (xcd & 3) * 64 + j * 2 + k; qh = kvh * 4 + (ii >> 6); qb = ii & 63; t0 = (size_t)MPROMPT; seq = SEQS; }
    else { const int b = xcd >> 1; kvh = xcd & 1; const int ii = j * 2 + (k - 2); qh = kvh * 4 + (ii >> 4); qb = ii & 15; t0 = (size_t)b * SEQP; seq = SEQP; }
    bf16_t* qp = MIX + (t0 + (size_t)qb * 256) * 2048 + qh * 128;
    att::attn_dense_body<2048, 256, 2048>(qp, KA + t0 * 256 + kvh * 128, VA + t0 * 256 + kvh * 128, qp, seq, lds, nostore);
}

template <class Epi>
__device__ __forceinline__ void run_gemm(char* lds, const bf16_t* A, const bf16_t* Bt, int M, int N, int K, int G, const Epi& E) {
    pg8::Gemm g{A, Bt, M, N, K}; pg8::StaticOrder S; S.init(M, N, G, (int)blockIdx.x);
    pg8::gemm_phase<Epi, pg8::StaticOrder, true, true>((PG8_LAS unsigned char*)lds, g, S, E);
}

__global__ void __launch_bounds__(NTHR, 2) mk_fwd(Args a) {
    extern __shared__ __attribute__((aligned(16))) unsigned char lds_raw[];
    char* lds = (char*)lds_raw;
    const int G = gridDim.x, lo = a.ph_lo, hi = a.ph_hi;
    unsigned char* ws = a.ws; unsigned char* dob = (unsigned char*)a.out;
    cg::grid_group grid = cg::this_grid();
    volatile LAS unsigned* bst = (volatile LAS unsigned*)((LAS unsigned char*)lds_raw + 143360);
    if (threadIdx.x < 2) bst[threadIdx.x] = 0u;
    __syncthreads();
    XcdBarrier bar = xcd_barrier_post((unsigned*)(ws + WS_BAR), bst);
#ifndef PHMASK
#define PHMASK 0xFFFF
#endif
#define IN(k) ((((PHMASK) >> (k)) & 1) && lo <= (k) && (k) < hi)
#ifndef PROBE_REP
#define PROBE_REP -1
#endif
#define REPS(k) ((PROBE_REP == (k)) ? 2 : 1)
#define SEAM(k) do { if (IN(k) && IN((k) + 1)) { if (a.use_cg) grid.sync(); else xcd_barrier(bar); } } while (0)
    if (PROBE_REP == 99) { for (int rp = 0; rp < 20; ++rp) xcd_barrier(bar); }
    if (IN(0)) { for (int rp = 0; rp < REPS(0); ++rp) p0_prologue(a, lds_raw, G); } SEAM(0);
    if (IN(1)) { pg8::EpiSplit E{(bf16_t*)(ws + WS_MIX), (bf16_t*)(ws + WS_KA), (bf16_t*)(ws + WS_VA), (bf16_t*)(ws + WS_QG), (bf16_t*)(ws + WS_KG), (bf16_t*)(ws + WS_VG), (float*)(ws + WS_LR)};
        for (int rp = 0; rp < REPS(1); ++rp) run_gemm(lds, (const bf16_t*)(dob + DO_H), (const bf16_t*)(ws + WS_WIN), MTOK, DINP, DM, G, E); } SEAM(1);
    if (IN(2)) { for (int rp = 0; rp < REPS(20); ++rp) { int ns = (rp + 1 < REPS(20)); asm volatile("" : "+s"(ns)); qk_norm_rope(a, G, ns); } for (int rp = 0; rp < REPS(2); ++rp) for (int u = blockIdx.x; u < 512; u += G) g1_unit(a, lds, u >> 2, u & 3); } SEAM(2);
    if (IN(3)) { for (int rp = 0; rp < REPS(3); ++rp) g2_scan(a, G); } SEAM(3);
    if (IN(4)) {
#ifndef NO_ATT
        for (int rp = 0; rp < REPS(40); ++rp) { int ns = (rp + 1 < REPS(40)); asm volatile("" : "+s"(ns)); for (int i = blockIdx.x; i < 1024; i += G) att_item(a, lds, i, ns); }
#endif
        asm volatile("" ::: "memory");
#ifndef NO_G3
        for (int rp = 0; rp < REPS(41); ++rp) { int ns = (rp + 1 < REPS(41)); asm volatile("" : "+s"(ns)); for (int g = blockIdx.x; g < 1024; g += G) g3_unit(a, lds, g >> 3, (g >> 1) & 3, g & 1, ns); }
#endif
    } SEAM(4);
    if (IN(5)) { pg8::EpiPlain E{(bf16_t*)(ws + WS_M1), DM}; for (int rp = 0; rp < REPS(5); ++rp) run_gemm(lds, (const bf16_t*)(ws + WS_MIX), (const bf16_t*)(ws + WS_WOUT), MTOK, DM, DM, G, E); } SEAM(5);
    if (IN(6)) { for (int rp = 0; rp < REPS(6); ++rp) row_pass<true, true>(a, G, (const bf16_t*)(ws + WS_M1), a.in[I_GPOSTMIX], a.in[I_GPREFFN], (bf16_t*)(ws + WS_XN)); } SEAM(6);
#pragma unroll
    for (int half = 0; half < 2; ++half) {
        const size_t roff = (size_t)half * (MTOK / 2) * DM;
        if (IN(7 + 2 * half)) { pg8::EpiSwiGLU E{(bf16_t*)(ws + WS_HFF), DFF}; for (int rp = 0; rp < REPS(7 + 2 * half); ++rp) run_gemm(lds, (const bf16_t*)(ws + WS_XN) + roff, (const bf16_t*)(ws + WS_WGU), MTOK / 2, 2 * DFF, DM, G, E); } SEAM(7 + 2 * half);
        if (IN(8 + 2 * half)) { pg8::EpiPlain E{(bf16_t*)(ws + WS_XN) + roff, DM}; for (int rp = 0; rp < REPS(8 + 2 * half); ++rp) run_gemm(lds, (const bf16_t*)(ws + WS_HFF), (const bf16_t*)(ws + WS_WDN), MTOK / 2, DM, DFF, G, E); } SEAM(8 + 2 * half);
    }
    if (IN(11)) { row_pass<false, true>(a, G, (const bf16_t*)(ws + WS_XN), a.in[I_GPOSTFFN], a.in[I_GPLEPRE], (bf16_t*)(ws + WS_XN)); } SEAM(11);
    if (IN(12)) { for (int rp = 0; rp < REPS(12); ++rp) { pg8::EpiPlain E0{(bf16_t*)(ws + WS_M3), DM}; run_gemm(lds, (const bf16_t*)(ws + WS_PB), (const bf16_t*)(ws + WS_WPP), MTOK, DM, DPLE, G, E0);
        pg8::EpiMulSig E1{(bf16_t*)(ws + WS_M3), DM}; run_gemm(lds, (const bf16_t*)(ws + WS_XN), (const bf16_t*)(ws + WS_WPG), MTOK, DM, DM, G, E1); } } SEAM(12);
    if (IN(13)) { row_pass<false, false>(a, G, (const bf16_t*)(ws + WS_M3), a.in[I_GPLEPOST], nullptr, nullptr); }
#undef IN
#undef SEAM
}
constexpr int NPHASE = 14;
}

extern "C" void kernel_launch(void* const* d_in, const int* in_sizes, int n_in, void* d_out, int out_size, void* d_ws, size_t ws_size, hipStream_t stream) {
    using namespace mk;
    static int grid = 0;
    if (grid == 0) {
        if (n_in != 23 || out_size != 2 * MPROMPT * DM || ws_size < WS_END) { fprintf(stderr, "kernel_launch: unexpected shapes n_in %d out %d ws %zu\n", n_in, out_size, ws_size); grid = -1; return; }
        int dev = 0, cus = 0, per_cu = 0;
        if (hipGetDevice(&dev) != hipSuccess || hipDeviceGetAttribute(&cus, hipDeviceAttributeMultiprocessorCount, dev) != hipSuccess) { grid = -1; return; }
        if (hipFuncSetAttribute((const void*)mk_fwd, hipFuncAttributeMaxDynamicSharedMemorySize, LDS_BYTES) != hipSuccess) { fprintf(stderr, "kernel_launch: hipFuncSetAttribute failed\n"); grid = -1; return; }
        if (hipOccupancyMaxActiveBlocksPerMultiprocessor(&per_cu, (const void*)mk_fwd, NTHR, LDS_BYTES) != hipSuccess || per_cu < 1) { fprintf(stderr, "kernel_launch: occupancy query says %d\n", per_cu); per_cu = 1; }
        (void)hipGetLastError();
        grid = cus * per_cu;
    }
    if (grid < 0) return;
    Args a{};
    for (int i = 0; i < 23; ++i) a.in[i] = (const float*)d_in[i];
    a.out = (float*)d_out; a.ws = (unsigned char*)d_ws; a.use_cg = 0; a.pad = 0;
    if (hipMemsetAsync((char*)d_ws + WS_BAR, 0, WS_BAR_BYTES, stream) != hipSuccess) { fprintf(stderr, "kernel_launch: memset failed\n"); return; }
#if ONE_LAUNCH
    a.ph_lo = 0; a.ph_hi = NPHASE;
    void* args[] = {&a};
    hipError_t e = hipLaunchCooperativeKernel((const void*)mk_fwd, dim3(grid), dim3(NTHR), args, LDS_BYTES, stream);
    if (e != hipSuccess) fprintf(stderr, "cooperative launch failed: %s (grid %d)\n", hipGetErrorString(e), grid);
#else
    for (int p = 0; p < NPHASE; ++p) { a.ph_lo = p; a.ph_hi = p + 1; hipLaunchKernelGGL(mk_fwd, dim3(grid), dim3(NTHR), LDS_BYTES, stream, a); }
#endif
}
```
